# Optimizing an MI355X kernel written in HIP

```python
import jax, jax.numpy as jnp
from jax import lax
import numpy as np

D_MODEL = 1024
BATCH = 8
SEQ = 2048
DEPTH = 2

HEAD_SIZE = 64
D_RWKV = D_MODEL
N_HEADS_RWKV = D_RWKV // HEAD_SIZE
DECAY_RANK = 64
AAA_RANK = 64
GATE_RANK = 128
VRES_RANK = 32
D_CONV = D_MODEL
CONV_WIDTH = 31
D_FF = 4 * D_MODEL

RMS_EPS = 1e-6
LN_EPS = 1e-5
GN_EPS = 64e-5

N_SHIFT = 3 * D_RWKV + DECAY_RANK + AAA_RANK + GATE_RANK
N_COLS = N_SHIFT + 2 * D_CONV + D_RWKV + D_CONV
RWKV_SPLITS = [D_RWKV, 2 * D_RWKV, 3 * D_RWKV, 3 * D_RWKV + DECAY_RANK, 3 * D_RWKV + DECAY_RANK + AAA_RANK]

kernel_name = "rwkv7_conformer_gated_hybrid"


def _rms_norm(x, g):
    xf = x.astype(jnp.float32)
    y = xf * lax.rsqrt(jnp.mean(xf * xf, axis=-1, keepdims=True) + RMS_EPS)
    return y.astype(x.dtype) * g


def _layer_norm(z, g, b):
    zf = z.astype(jnp.float32)
    mu = jnp.mean(zf, axis=-1, keepdims=True)
    var = jnp.mean(jnp.square(zf - mu), axis=-1, keepdims=True)
    return ((zf - mu) * lax.rsqrt(var + LN_EPS)).astype(z.dtype) * g + b


def _token_shift(p, mu):
    p_prev = jnp.pad(p, ((0, 0), (1, 0), (0, 0)))[:, :-1]
    return p + (p_prev - p) * mu


def _rwkv7_scan(r, decay, k, v, a, b):
    bsz, _, h, n = r.shape

    def step(S, inp):
        r_t, w_t, k_t, v_t, a_t, b_t = inp
        sa = jnp.einsum('bhij,bhj->bhi', S, a_t)
        S = S * w_t[:, :, None, :] + sa[..., None] * b_t[:, :, None, :] + v_t[..., None] * k_t[:, :, None, :]
        return S, jnp.einsum('bhij,bhj->bhi', S, r_t)

    seq_major = tuple(jnp.moveaxis(t, 1, 0) for t in (r, decay, k, v, a, b))
    s0 = jnp.zeros((bsz, h, n, n), jnp.float32)
    _, y = lax.scan(step, s0, seq_major)
    return jnp.moveaxis(y, 0, 1)


def _rwkv7_time_mix(xs, v_first, vres, w0, w_decay_up, a0, w_aaa_up, w_gate_up,
                    k_k, k_a, r_k, gn_gain, gn_bias):
    bsz, t, _ = xs.shape
    r, k, v, w_lo, a_lo, g_lo = jnp.split(xs, RWKV_SPLITS, axis=-1)
    w = -jax.nn.softplus(-(w0 + jnp.tanh(w_lo) @ w_decay_up)) - 0.5
    a = jax.nn.sigmoid(a0 + a_lo @ w_aaa_up)
    g = jax.nn.sigmoid(g_lo) @ w_gate_up
    if v_first is None:
        v_first = v
    else:
        v_lo, v0, w_vres_up = vres
        v = v + (v_first - v) * jax.nn.sigmoid(v0 + v_lo @ w_vres_up)
    heads = lambda z: z.reshape(bsz, t, N_HEADS_RWKV, HEAD_SIZE).astype(jnp.float32)
    kk = heads(k * k_k)
    kk = kk / jnp.maximum(jnp.sqrt(jnp.sum(kk * kk, axis=-1, keepdims=True)), 1e-12)
    k = k * (1.0 + (a - 1.0) * k_a)
    rh, kh, vh, ah = heads(r), heads(k), heads(v), heads(a)
    decay = jnp.exp(-jnp.exp(heads(w)))
    y = _rwkv7_scan(rh, decay, kh, vh, -kk, kk * ah)
    mu = jnp.mean(y, axis=-1, keepdims=True)
    var = jnp.mean(jnp.square(y - mu), axis=-1, keepdims=True)
    y = (y - mu) * lax.rsqrt(var + GN_EPS)
    y = y.reshape(bsz, t, D_RWKV).astype(xs.dtype) * gn_gain + gn_bias
    bonus = (jnp.sum(rh * kh * r_k, axis=-1, keepdims=True) * vh).reshape(bsz, t, D_RWKV).astype(xs.dtype)
    return (y + bonus) * g, v_first


def _conformer_conv(u, conv_w, conv_b, ln_gain, ln_bias):
    glu = u[..., :D_CONV] * jax.nn.sigmoid(u[..., D_CONV:])
    z = lax.conv_general_dilated(
        glu, conv_w[:, None, :].astype(glu.dtype), window_strides=(1,),
        padding=((CONV_WIDTH - 1, 0),), dimension_numbers=('NWC', 'WIO', 'NWC'),
        feature_group_count=D_CONV) + conv_b
    return jax.nn.silu(_layer_norm(z, ln_gain, ln_bias))


def setup_inputs(seed: int = 0) -> dict:
    key = jax.random.key(seed)
    ks = iter(jax.random.split(key, 40))
    L, LV = DEPTH, DEPTH - 1

    def nrm(shape, s):
        return jax.random.normal(next(ks), shape, jnp.float32) * s

    def unif(shape, lo, hi):
        return jax.random.uniform(next(ks), shape, jnp.float32, lo, hi)

    return {
        "x": nrm((BATCH, SEQ, D_MODEL), 1.0),
        "c": nrm((BATCH, D_MODEL), 1.0),
        "norm_mix_gain": 1.0 + nrm((L, D_MODEL), 0.02),
        "norm_ffn_gain": 1.0 + nrm((L, D_MODEL), 0.02),
        "ada_w": nrm((L, D_MODEL, 6 * D_MODEL), 0.3 * D_MODEL ** -0.5),
        "ada_b": nrm((L, 6 * D_MODEL), 0.01),
        "w_in": nrm((L, D_MODEL, N_COLS), D_MODEL ** -0.5),
        "w_in_vres": nrm((LV, D_MODEL, VRES_RANK), D_MODEL ** -0.5),
        "mu_shift": unif((L, N_SHIFT), 0.0, 1.0),
        "mu_vres": unif((LV, VRES_RANK), 0.0, 1.0),
        "w0": unif((L, D_RWKV), -6.0, -1.0),
        "w_decay_up": nrm((L, DECAY_RANK, D_RWKV), 0.5 * DECAY_RANK ** -0.5),
        "a0": nrm((L, D_RWKV), 0.1),
        "w_aaa_up": nrm((L, AAA_RANK, D_RWKV), AAA_RANK ** -0.5),
        "w_gate_up": nrm((L, GATE_RANK, D_RWKV), GATE_RANK ** -0.5),
        "k_k": 0.85 + nrm((L, D_RWKV), 0.05),
        "k_a": 1.0 + nrm((L, D_RWKV), 0.05),
        "r_k": nrm((L, N_HEADS_RWKV, HEAD_SIZE), 0.1),
        "gn_gain": 1.0 + nrm((L, D_RWKV), 0.02),
        "gn_bias": nrm((L, D_RWKV), 0.01),
        "v0": nrm((LV, D_RWKV), 0.1),
        "w_vres_up": nrm((LV, VRES_RANK, D_RWKV), VRES_RANK ** -0.5),
        "conv_w": nrm((L, CONV_WIDTH, D_CONV), CONV_WIDTH ** -0.5),
        "conv_b": nrm((L, D_CONV), 0.01),
        "conv_ln_gain": 1.0 + nrm((L, D_CONV), 0.02),
        "conv_ln_bias": nrm((L, D_CONV), 0.01),
        "w_out": nrm((L, D_RWKV + D_CONV, D_MODEL), (D_RWKV + D_CONV) ** -0.5),
        "w_ff_in": nrm((L, D_MODEL, D_FF), D_MODEL ** -0.5),
        "w_ff_out": nrm((L, D_FF, D_MODEL), D_FF ** -0.5),
        "final_gain": 1.0 + nrm((D_MODEL,), 0.02),
    }


def reference(x, c, norm_mix_gain, norm_ffn_gain, ada_w, ada_b, w_in, w_in_vres, mu_shift, mu_vres,
              w0, w_decay_up, a0, w_aaa_up, w_gate_up, k_k, k_a, r_k, gn_gain, gn_bias, v0, w_vres_up,
              conv_w, conv_b, conv_ln_gain, conv_ln_bias, w_out, w_ff_in, w_ff_out, final_gain):
    c_act = jax.nn.silu(c)
    v_first = None
    for l in range(DEPTH):
        mod = c_act @ ada_w[l] + ada_b[l]
        sh_m, sc_m, gt_m, sh_f, sc_f, gt_f = [m[:, None, :] for m in jnp.split(mod, 6, axis=-1)]

        h = _rms_norm(x, norm_mix_gain[l]) * (1.0 + sc_m) + sh_m
        w_comb = w_in[l] if l == 0 else jnp.concatenate([w_in[l], w_in_vres[l - 1]], axis=1)
        proj = h @ w_comb
        rwkv_in = _token_shift(proj[..., :N_SHIFT], mu_shift[l])
        conv_in = proj[..., N_SHIFT:N_SHIFT + 2 * D_CONV]
        gates = jax.nn.sigmoid(proj[..., N_SHIFT + 2 * D_CONV:N_COLS])
        vres = None if l == 0 else (_token_shift(proj[..., N_COLS:], mu_vres[l - 1]), v0[l - 1], w_vres_up[l - 1])
        y_a, v_first = _rwkv7_time_mix(rwkv_in, v_first, vres, w0[l], w_decay_up[l], a0[l], w_aaa_up[l],
                                       w_gate_up[l], k_k[l], k_a[l], r_k[l], gn_gain[l], gn_bias[l])
        y_b = _conformer_conv(conv_in, conv_w[l], conv_b[l], conv_ln_gain[l], conv_ln_bias[l])
        merged = jnp.concatenate([y_a, y_b], axis=-1) * gates
        x = x + gt_m * (merged @ w_out[l])

        h = _rms_norm(x, norm_ffn_gain[l]) * (1.0 + sc_f) + sh_f
        x = x + gt_f * (jnp.square(jax.nn.relu(h @ w_ff_in[l])) @ w_ff_out[l])
    return _rms_norm(x, final_gain)
```

```cpp
#include <hip/hip_runtime.h>
#include <hip/hip_cooperative_groups.h>
#include <cstdio>
namespace cg = cooperative_groups;

#ifndef MULTI_LAUNCH
#define MULTI_LAUNCH 0
#endif

#define LAS __attribute__((address_space(3)))
typedef unsigned short bf16_t;
typedef short bf16x8 __attribute__((ext_vector_type(8)));
typedef float f32x4 __attribute__((ext_vector_type(4)));
typedef float f32x2 __attribute__((ext_vector_type(2)));
typedef unsigned u32x4 __attribute__((ext_vector_type(4)));
typedef unsigned u32x2 __attribute__((ext_vector_type(2)));

constexpr int NB = 8, T = 2048, D = 1024, M = NB * T, NH = 16, DFF = 4096;
constexpr int NCOLS = 7424, NP0 = 7424, NP1 = 7680, LDP = 6656;
constexpr int OFF_GLU = 3328, OFF_GA = 4352, OFF_GB = 5376, OFF_VLO = 6400;
constexpr int LDS_BYTES = 163840;

constexpr size_t WS_PROJ = 0;
constexpr size_t WS_H    = (size_t)M * LDP * 2;
constexpr size_t WS_MOD  = WS_H + (size_t)M * D * 2;
constexpr size_t WS_CTR  = WS_MOD + 2 * 8 * 6144 * 4;
constexpr size_t WS_LOA  = WS_CTR + 256;
constexpr size_t WS_BAR  = WS_LOA + (size_t)M * 288 * 2;
constexpr size_t WS_END  = WS_BAR + 16384;
constexpr size_t G_MERGED = 0;
constexpr size_t G_VFIRST = G_MERGED + (size_t)M * 2048 * 2;
constexpr size_t G_WIN    = G_VFIRST + (size_t)M * 1024 * 2;
constexpr size_t G_WOUT   = G_WIN + (size_t)2 * 7680 * 1024 * 2;
constexpr size_t G_WF1    = G_WOUT + (size_t)2 * 1024 * 2048 * 2;
constexpr size_t G_WF2    = G_WF1 + (size_t)2 * 4096 * 1024 * 2;
constexpr size_t G_END    = G_WF2 + (size_t)2 * 1024 * 4096 * 2;
__device__ __attribute__((aligned(256))) unsigned char g_buf[G_END];

struct Params {
    const float *x, *c, *norm_mix_gain, *norm_ffn_gain, *ada_w, *ada_b, *w_in, *w_in_vres, *mu_shift, *mu_vres,
        *w0, *w_decay_up, *a0, *w_aaa_up, *w_gate_up, *k_k, *k_a, *r_k, *gn_gain, *gn_bias, *v0, *w_vres_up,
        *conv_w, *conv_b, *conv_ln_gain, *conv_ln_bias, *w_out, *w_ff_in, *w_ff_out, *final_gain;
    float* out; unsigned char* ws;
};
#if defined(__HIP_DEVICE_COMPILE__)
typedef const __attribute__((address_space(4))) Params* KParamsPtr;
#else
typedef const Params* KParamsPtr;
#endif

__device__ __forceinline__ int otid() { int t = threadIdx.x; asm volatile("" : "+v"(t)); return t; }
__device__ __forceinline__ int obid() { int t = blockIdx.x; asm volatile("" : "+s"(t)); return t; }
__device__ __forceinline__ float bf2f(bf16_t v) { return __uint_as_float(((unsigned)v) << 16); }
__device__ __forceinline__ float bflo(unsigned w) { return __uint_as_float(w << 16); }
__device__ __forceinline__ float bfhi(unsigned w) { return __uint_as_float(w & 0xffff0000u); }
__device__ __forceinline__ unsigned cvt_pk_bf16(float lo, float hi) { unsigned r; asm volatile("v_cvt_pk_bf16_f32 %0, %1, %2" : "=v"(r) : "v"(lo), "v"(hi)); return r; }
__device__ __forceinline__ float sigm(float x) { return __builtin_amdgcn_rcpf(1.0f + __expf(-x)); }
template <int CTRL> __device__ __forceinline__ float dppf(float x) { return __builtin_bit_cast(float, __builtin_amdgcn_update_dpp(0, __builtin_bit_cast(int, x), CTRL, 0xF, 0xF, false)); }
__device__ __forceinline__ float red16(float x) { x += dppf<0xB1>(x); x += dppf<0x4E>(x); x += dppf<0x124>(x); x += dppf<0x128>(x); return x; }
__device__ __forceinline__ float red64(float x) { x = red16(x); x += __shfl_xor(x, 16); x += __shfl_xor(x, 32); return x; }

namespace pg8 {
constexpr int BM = 256, BK = 64, HALF = 128, HTB = HALF * BK * 2, STAGE_BYTES = 8 * HTB, NXCD = 8, WGM = 8;
__host__ __device__ __forceinline__ int lds_byte(int r, int c) { const int st = (r >> 4) * 2 + (c >> 5), rr = r & 15, cc = c & 31, ob = rr * 64 + cc * 2; return st * 1024 + (ob ^ (((ob >> 9) & 1) << 5)); }
__host__ __device__ __forceinline__ void stage_rc(int b, int& R, int& C) { const int st = b / 1024, sb = b % 1024, swz = sb ^ (((sb >> 9) & 1) << 5); R = (st >> 1) * 16 + swz / 64; C = (st & 1) * 32 + (swz % 64) / 2; }
__host__ __device__ __forceinline__ int perm32(int rho) { const int n = rho >> 4, i = rho & 15; return 8 * (i >> 2) + 4 * n + (i & 3); }
struct Unit { int pm, pn; };
struct Gemm { const bf16_t* A; const bf16_t* Bt; int M, N, K; };
struct StaticOrder {
    int nM, nN, nwg, G, c;
    __device__ void init(int M_, int N_, int G_, int c_) { nM = M_ / BM; nN = N_ / BM; nwg = nM * nN; G = G_; c = c_; }
    __device__ bool next(int i, Unit& u) const {
        const long L = (long)i * G + c; if (L >= nwg) return false;
        int wgid = (int)L; { const int q = nwg / NXCD, r = nwg % NXCD, xcd = wgid % NXCD, off = wgid / NXCD; wgid = (xcd < r ? xcd * (q + 1) : r * (q + 1) + (xcd - r) * q) + off; }
        const int nig = WGM * nN, gid = wgid / nig, fm = gid * WGM, gsz = (nM - fm) < WGM ? (nM - fm) : WGM;
        u.pm = fm + ((wgid % nig) % gsz); u.pn = (wgid % nig) / gsz; return true;
    }
};

template <class Epi>
__device__ __forceinline__ void gemm_phase(LAS unsigned char* lds, const Gemm g, const StaticOrder& S, const Epi& E) {
    const int tid = otid(), wid = __builtin_amdgcn_readfirstlane(tid >> 6), lane = tid & 63, wr = wid >> 2, wc = wid & 3, fr = lane & 15, fq = lane >> 4;
    const int K = g.K, nt = K / BK;
    unsigned voffA[2], voffB[2];
#pragma unroll
    for (int i = 0; i < 2; ++i) { int R, C; stage_rc(tid * 16 + i * 8192, R, C); const int Rb = Epi::PERM ? ((R & ~31) + perm32(R & 31)) : R;
        voffA[i] = (unsigned)(R * K + C) * 2u; voffB[i] = (unsigned)(Rb * K + C) * 2u; }
    const size_t kstep = (size_t)(BK * 2);
    const size_t hstep = (size_t)HALF * K * 2;
    const size_t tstep = 2 * hstep;
    const unsigned ldsw = (unsigned)wid * 1024u;
    const int aoff = lds_byte(wr * 64 + fr, fq * 8), boff = lds_byte(wc * 32 + fr, fq * 8);
#define PG8_SA(b, h) (((b) * 2 + (h)) * HTB)
#define PG8_SB(b, h) ((4 + (b) * 2 + (h)) * HTB)
#define PG8_STAGE(bufoff, gbase, voff) do { _Pragma("unroll") for (int _i = 0; _i < 2; ++_i) \
        __builtin_amdgcn_global_load_lds((const unsigned*)((const char*)(gbase) + (voff)[_i]), (LAS unsigned*)(lds + (bufoff) + ldsw + _i * 8192), 16, 0, 0); } while (0)
#define PG8_LDA(dst, b, h) do { _Pragma("unroll") for (int m = 0; m < 4; ++m) _Pragma("unroll") for (int k = 0; k < 2; ++k) dst[m][k] = *(const LAS bf16x8*)(lds + PG8_SA(b, h) + aoff + m * 2048 + k * 1024); } while (0)
#define PG8_LDB(dst, b, h) do { _Pragma("unroll") for (int n = 0; n < 2; ++n) _Pragma("unroll") for (int k = 0; k < 2; ++k) dst[n][k] = *(const LAS bf16x8*)(lds + PG8_SB(b, h) + boff + n * 2048 + k * 1024); } while (0)
#define PG8_MMA(ai, bj, At, Bt) do { __builtin_amdgcn_s_setprio(1); _Pragma("unroll") for (int m = 0; m < 4; ++m) _Pragma("unroll") for (int n = 0; n < 2; ++n) _Pragma("unroll") for (int k = 0; k < 2; ++k) \
        acc[ai][bj][m][n] = __builtin_amdgcn_mfma_f32_16x16x32_bf16(Bt[n][k], At[m][k], acc[ai][bj][m][n], 0, 0, 0); __builtin_amdgcn_s_setprio(0); } while (0)
#define PG8_WAIT_V(n) asm volatile("s_waitcnt vmcnt(" #n ")" ::: "memory")
#define PG8_WAIT_L(n) asm volatile("s_waitcnt lgkmcnt(" #n ")" ::: "memory")
#define PG8_BAR __builtin_amdgcn_s_barrier()
#define PG8_SCHED __builtin_amdgcn_sched_barrier(0)
    Unit cur, nxt; int ui = 0;
    if (!S.next(0, cur)) return;
    f32x4 acc[2][2][4][2];
#pragma unroll
    for (int a = 0; a < 2; ++a)
#pragma unroll
        for (int b = 0; b < 2; ++b)
#pragma unroll
            for (int m = 0; m < 4; ++m)
#pragma unroll
                for (int n = 0; n < 2; ++n) acc[a][b][m][n] = (f32x4){0.f, 0.f, 0.f, 0.f};
    bf16x8 At[4][2], B0[2][2], B1[2][2];
    const char* cA = (const char*)g.A + (size_t)cur.pm * tstep; const char* cB = (const char*)g.Bt + (size_t)cur.pn * tstep;
    PG8_STAGE(PG8_SB(0, 0), cB, voffB); PG8_STAGE(PG8_SA(0, 0), cA, voffA); PG8_STAGE(PG8_SB(0, 1), cB + hstep, voffB); PG8_STAGE(PG8_SA(0, 1), cA + hstep, voffA);
    if (wr == 1) PG8_BAR;
    PG8_WAIT_V(4); PG8_BAR;
    PG8_STAGE(PG8_SB(1, 0), cB + kstep, voffB); PG8_STAGE(PG8_SA(1, 0), cA + kstep, voffA); PG8_STAGE(PG8_SB(1, 1), cB + hstep + kstep, voffB);
    PG8_WAIT_V(6); PG8_BAR;
    for (;;) {
        const bool has_next = S.next(ui + 1, nxt);
        const char* nA = has_next ? (const char*)g.A + (size_t)nxt.pm * tstep : cA; const char* nB = has_next ? (const char*)g.Bt + (size_t)nxt.pn * tstep : cB;
        for (int t = 0; t < nt; t += 2) {
            const bool last = (t == nt - 2);
            const char* a1 = cA + (size_t)(t + 1) * kstep;
            const char* a2 = last ? nA : cA + (size_t)(t + 2) * kstep; const char* b2 = last ? nB : cB + (size_t)(t + 2) * kstep;
            const char* a3 = a2 + kstep; const char* b3 = b2 + kstep;
            PG8_LDB(B0, 0, 0); PG8_SCHED; PG8_LDA(At, 0, 0); PG8_STAGE(PG8_SA(1, 1), a1 + hstep, voffA);
            PG8_WAIT_L(8); PG8_BAR; PG8_WAIT_L(0); PG8_MMA(0, 0, At, B0); PG8_BAR; PG8_SCHED;
            PG8_LDB(B1, 0, 1); PG8_STAGE(PG8_SB(0, 0), b2, voffB);
            PG8_BAR; PG8_WAIT_L(0); PG8_MMA(0, 1, At, B1); PG8_BAR;
            PG8_LDA(At, 0, 1); PG8_STAGE(PG8_SA(0, 0), a2, voffA);
            PG8_BAR; PG8_WAIT_L(0); PG8_MMA(1, 0, At, B0); PG8_BAR; PG8_SCHED;
            PG8_STAGE(PG8_SB(0, 1), b2 + hstep, voffB);
            PG8_WAIT_V(6); PG8_BAR; PG8_MMA(1, 1, At, B1); PG8_BAR;
            PG8_LDB(B0, 1, 0); PG8_SCHED; PG8_LDA(At, 1, 0); PG8_STAGE(PG8_SA(0, 1), a2 + hstep, voffA);
            PG8_WAIT_L(8); PG8_BAR; PG8_WAIT_L(0); PG8_MMA(0, 0, At, B0); PG8_BAR; PG8_SCHED;
            PG8_LDB(B1, 1, 1); PG8_STAGE(PG8_SB(1, 0), b3, voffB);
            PG8_BAR; PG8_WAIT_L(0); PG8_MMA(0, 1, At, B1); PG8_BAR;
            PG8_LDA(At, 1, 1); PG8_STAGE(PG8_SA(1, 0), a3, voffA);
            PG8_BAR; PG8_WAIT_L(0); PG8_MMA(1, 0, At, B0); PG8_BAR; PG8_SCHED;
            PG8_STAGE(PG8_SB(1, 1), b3 + hstep, voffB);
            PG8_WAIT_V(6); PG8_BAR; PG8_MMA(1, 1, At, B1); PG8_BAR;
        }
        E(acc, cur, wr, wc, fr, fq);
        if (!has_next) break;
#pragma unroll
        for (int a = 0; a < 2; ++a)
#pragma unroll
            for (int b = 0; b < 2; ++b)
#pragma unroll
                for (int m = 0; m < 4; ++m)
#pragma unroll
                    for (int n = 0; n < 2; ++n) acc[a][b][m][n] = (f32x4){0.f, 0.f, 0.f, 0.f};
        cur = nxt; cA = nA; cB = nB; ++ui;
    }
    PG8_WAIT_V(0);
    if (wr == 0) PG8_BAR;
    PG8_BAR;
#undef PG8_SA
#undef PG8_SB
#undef PG8_STAGE
#undef PG8_LDA
#undef PG8_LDB
#undef PG8_MMA
#undef PG8_WAIT_V
#undef PG8_WAIT_L
#undef PG8_BAR
#undef PG8_SCHED
}

struct Epi {
    static constexpr bool PERM = true;
    int kind; bf16_t* O; const float* xin; float* xout; const float* gate; int pn0, lv;
    __device__ __forceinline__ void operator()(const f32x4 (&acc)[2][2][4][2], const Unit& u, int wr, int wc, int fr, int fq) const {
        const int row0 = u.pm * BM + wr * 64 + fr; const int pn = u.pn; const int cin = wc * 32 + 8 * fq;
        const int pa = pn + pn0, tt = pa - 17 - lv;
        const bool is_glu = kind == 0 && pa >= 17 && !(lv && pa == 17) && tt < 8;
        if (kind == 2) {
            const int col0 = pn * BM + cin;
            const float* gp = gate + (size_t)(u.pm >> 3) * 6144 + col0;
#pragma unroll
            for (int bj = 0; bj < 2; ++bj) {
                const f32x4 g0 = *(const f32x4*)(gp + bj * HALF), g1 = *(const f32x4*)(gp + bj * HALF + 4);
#pragma unroll
                for (int ai = 0; ai < 2; ++ai) {
                    f32x4 x0[4], x1[4];
#pragma unroll
                    for (int m = 0; m < 4; ++m) { const size_t ro = (size_t)(row0 + ai * HALF + m * 16) * D + col0 + bj * HALF; x0[m] = *(const f32x4*)(xin + ro); x1[m] = *(const f32x4*)(xin + ro + 4); }
#pragma unroll
                    for (int m = 0; m < 4; ++m) { const size_t ro = (size_t)(row0 + ai * HALF + m * 16) * D + col0 + bj * HALF;
                        *(f32x4*)(xout + ro) = x0[m] + g0 * acc[ai][bj][m][0]; *(f32x4*)(xout + ro + 4) = x1[m] + g1 * acc[ai][bj][m][1]; } } }
        } else if (is_glu) {
            const int col = OFF_GLU + tt * 128 + cin;
#pragma unroll
            for (int ai = 0; ai < 2; ++ai)
#pragma unroll
                for (int m = 0; m < 4; ++m) { bf16_t* rowp = O + (size_t)(row0 + ai * HALF + m * 16) * LDP + col;
                    f32x4 a0 = acc[ai][0][m][0], a1 = acc[ai][0][m][1], b0 = acc[ai][1][m][0], b1 = acc[ai][1][m][1];
                    u32x4 w; w.x = cvt_pk_bf16(a0[0] * sigm(b0[0]), a0[1] * sigm(b0[1])); w.y = cvt_pk_bf16(a0[2] * sigm(b0[2]), a0[3] * sigm(b0[3]));
                    w.z = cvt_pk_bf16(a1[0] * sigm(b1[0]), a1[1] * sigm(b1[1])); w.w = cvt_pk_bf16(a1[2] * sigm(b1[2]), a1[3] * sigm(b1[3]));
                    *(u32x4*)rowp = w; }
        } else {
            const int mode = kind == 1 ? 2 : ((pa >= 13 && !(lv && pa == 17)) ? 1 : 0);
            const int ldo = kind == 1 ? DFF : LDP;
            const int col = (kind == 1 ? pn * 256 : (pa < 13 ? pa * 256 : (pa < 17 ? OFF_GA + (pa - 13) * 256 : ((lv && pa == 17) ? OFF_VLO : OFF_GB + (tt - 8) * 256)))) + cin;
#pragma unroll
            for (int ai = 0; ai < 2; ++ai)
#pragma unroll
                for (int m = 0; m < 4; ++m) { bf16_t* rowp = O + (size_t)(row0 + ai * HALF + m * 16) * ldo + col;
#pragma unroll
                    for (int bj = 0; bj < 2; ++bj) { f32x4 v0 = acc[ai][bj][m][0], v1 = acc[ai][bj][m][1];
                        if (mode == 1) {
#pragma unroll
                            for (int j = 0; j < 4; ++j) { v0[j] = sigm(v0[j]); v1[j] = sigm(v1[j]); } }
                        else if (mode == 2) {
#pragma unroll
                            for (int j = 0; j < 4; ++j) { const float a = fmaxf(v0[j], 0.f), b = fmaxf(v1[j], 0.f); v0[j] = a * a; v1[j] = b * b; } }
                        u32x4 w; w.x = cvt_pk_bf16(v0[0], v0[1]); w.y = cvt_pk_bf16(v0[2], v0[3]); w.z = cvt_pk_bf16(v1[0], v1[1]); w.w = cvt_pk_bf16(v1[2], v1[3]);
                        *(u32x4*)(rowp + bj * HALF) = w; } }
        }
    }
};
}

struct TileJob { const float* src; int ld, s0, nvalid; bf16_t* dst; int K, d0, k0; };
__device__ __forceinline__ void tile_load(const TileJob& t, f32x4 (&v)[2]) {
    const int tid = otid(); const int kk = tid >> 4, c4 = (tid & 15) * 4;
#pragma unroll
    for (int p = 0; p < 2; ++p) { v[p] = (f32x4){0.f, 0.f, 0.f, 0.f};
        if (t.src != nullptr && c4 < t.nvalid) v[p] = *(const f32x4*)(t.src + (size_t)(t.k0 + kk + 32 * p) * t.ld + t.s0 + c4); }
}
__device__ __forceinline__ void tile_store(const TileJob& t, const f32x4 (&v)[2], LAS float* tile) {
    const int tid = otid();
    { const int kk = tid >> 4, c4 = (tid & 15) * 4;
#pragma unroll
      for (int p = 0; p < 2; ++p) { const int k = kk + 32 * p;
          tile[k * 65 + c4 + 0] = v[p][0]; tile[k * 65 + c4 + 1] = v[p][1]; tile[k * 65 + c4 + 2] = v[p][2]; tile[k * 65 + c4 + 3] = v[p][3]; } }
    __syncthreads();
    { const int nn = tid >> 3, k8 = (tid & 7) * 8; float x[8];
#pragma unroll
      for (int j = 0; j < 8; ++j) x[j] = tile[(k8 + j) * 65 + nn];
      u32x4 w; w.x = cvt_pk_bf16(x[0], x[1]); w.y = cvt_pk_bf16(x[2], x[3]); w.z = cvt_pk_bf16(x[4], x[5]); w.w = cvt_pk_bf16(x[6], x[7]);
      *(u32x4*)(t.dst + (size_t)(t.d0 + nn) * t.K + t.k0 + k8) = w; }
    __syncthreads();
}

namespace pj {
constexpr int J_IN0 = (NP0 / 64) * 16, J_IN1 = (NP1 / 64) * 16, J_OUT = 16 * 32, J_F1 = 64 * 16, J_F2 = 16 * 64;
constexpr int E0 = J_IN0, E1 = E0 + J_IN1, E2 = E1 + 2 * J_OUT, E3 = E2 + 2 * J_F1, E4 = E3 + 2 * J_F2, TOT = E4 + 192;
}
__device__ __forceinline__ void tile_decode(KParamsPtr p, int j, TileJob& t) {
    using namespace pj;
    if (j < E1) {
        const int l = j < E0 ? 0 : 1; const int r = j - (l ? E0 : 0); const int nt = r >> 4, kt = r & 15; const int d0 = nt * 64;
        const float* src = p->w_in + (size_t)l * 1024 * NCOLS; int ld = NCOLS, s0 = d0, nvalid = 64;
        { const int tI = d0 >> 8, e = d0 & 255;
          if (tI < 13) s0 = d0;
          else if (tI < 17) s0 = 5376 + (tI - 13) * 256 + e;
          else if (l == 1 && tI == 17) { if (e == 0) { src = p->w_in_vres; ld = 32; s0 = 0; nvalid = 32; } else src = nullptr; }
          else { const int tt = tI - 17 - l; if (tt < 8) s0 = e < 128 ? 3328 + tt * 128 + e : 4352 + tt * 128 + (e - 128); else s0 = 6400 + (tt - 8) * 256 + e; } }
        t.src = src; t.ld = ld; t.s0 = s0; t.nvalid = nvalid; t.dst = (bf16_t*)(g_buf + G_WIN) + (size_t)l * 7680 * 1024; t.K = 1024; t.d0 = d0; t.k0 = kt * 64;
    } else if (j < E2) { const int r0 = j - E1; const int l = r0 / J_OUT, r = r0 % J_OUT; const int nt = r >> 5, kt = r & 31;
        t.src = p->w_out + (size_t)l * 2048 * 1024; t.ld = 1024; t.s0 = nt * 64; t.nvalid = 64; t.dst = (bf16_t*)(g_buf + G_WOUT) + (size_t)l * 1024 * 2048; t.K = 2048; t.d0 = nt * 64; t.k0 = kt * 64;
    } else if (j < E3) { const int r0 = j - E2; const int l = r0 / J_F1, r = r0 % J_F1; const int nt = r >> 4, kt = r & 15;
        t.src = p->w_ff_in + (size_t)l * 1024 * 4096; t.ld = 4096; t.s0 = nt * 64; t.nvalid = 64; t.dst = (bf16_t*)(g_buf + G_WF1) + (size_t)l * 4096 * 1024; t.K = 1024; t.d0 = nt * 64; t.k0 = kt * 64;
    } else { const int r0 = j - E3; const int l = r0 / J_F2, r = r0 % J_F2; const int nt = r >> 6, kt = r & 63;
        t.src = p->w_ff_out + (size_t)l * 4096 * 1024; t.ld = 1024; t.s0 = nt * 64; t.nvalid = 64; t.dst = (bf16_t*)(g_buf + G_WF2) + (size_t)l * 1024 * 4096; t.K = 4096; t.d0 = nt * 64; t.k0 = kt * 64;
    }
}
__device__ void prep_job(KParamsPtr p, int j, LAS float* lds) {
    using namespace pj;
    const int tid = otid();
    {
        if (j < E4) { TileJob t; tile_decode(p, j, t); f32x4 v[2]; tile_load(t, v); tile_store(t, v, lds);
        } else {
            const int mj = j - E4; const int l = mj / 96, n0 = (mj % 96) * 64;
            LAS float* cact = lds; LAS float* red = lds + 8192;
            for (int i = tid; i < 8192; i += 512) { const float v = p->c[i]; cact[i] = v * sigm(v); }
            __syncthreads();
            const int kq = tid >> 6, nn = tid & 63; float a[8];
#pragma unroll
            for (int b = 0; b < 8; ++b) a[b] = 0.f;
            const float* wp = p->ada_w + (size_t)l * 1024 * 6144 + n0 + nn;
#pragma unroll 16
            for (int k = kq * 128; k < kq * 128 + 128; ++k) { const float w = wp[(size_t)k * 6144];
#pragma unroll
                for (int b = 0; b < 8; ++b) a[b] += cact[b * 1024 + k] * w; }
#pragma unroll
            for (int b = 0; b < 8; ++b) red[(kq * 8 + b) * 64 + nn] = a[b];
            __syncthreads();
            { const int b = tid >> 6; float s = p->ada_b[l * 6144 + n0 + nn];
#pragma unroll
              for (int q = 0; q < 8; ++q) s += red[(q * 8 + b) * 64 + nn];
              ((float*)(p->ws + WS_MOD))[(size_t)(l * 8 + b) * 6144 + n0 + nn] = s; }
            __syncthreads();
        }
    }
}
constexpr int PREP_AT = pj::E0 + pj::J_F2;
__device__ void prep_phase(KParamsPtr p, LAS float* lds) {
    if (blockIdx.x == 0 && otid() < 8) ((int*)(p->ws + WS_CTR))[otid()] = 0;
    int a0 = blockIdx.x, aend = PREP_AT, astr = gridDim.x;
    if (gridDim.x == 256) { constexpr int NA = 2560; if (blockIdx.x >= 96) { a0 = blockIdx.x - 96; aend = NA; astr = 160; } else { a0 = NA + blockIdx.x; astr = 96; } }
    if (gridDim.x != 256 || blockIdx.x < 96) for (int m = blockIdx.x; m < 96; m += gridDim.x) prep_job(p, pj::E4 + m, lds);
    { int a = a0; TileJob tc, tn; f32x4 vc[2], vn[2];
      if (a < aend) { tile_decode(p, a < pj::E0 ? a : pj::E3 + (a - pj::E0), tc); tile_load(tc, vc); }
      for (; a < aend; a += astr) { const int an = a + astr; const bool more = an < aend;
          if (more) { tile_decode(p, an < pj::E0 ? an : pj::E3 + (an - pj::E0), tn); tile_load(tn, vn); }
          tile_store(tc, vc, lds);
          if (more) { tc = tn; vc[0] = vn[0]; vc[1] = vn[1]; } } }
}
constexpr int PREP_B0 = pj::J_IN1 + pj::J_OUT + pj::J_F1 + 96, PREP_B1 = pj::J_OUT + pj::J_F1 + pj::J_F2;
__device__ __forceinline__ int prep_b_job(int l, int q) {
    using namespace pj;
    if (l == 0) {
        if (q < J_IN1) return E0 + q; q -= J_IN1;
        if (q < J_OUT) return E1 + q; q -= J_OUT;
        if (q < J_F1) return E2 + q; q -= J_F1;
        return E4 + 96 + q;
    }
    if (q < J_OUT) return E1 + J_OUT + q; q -= J_OUT;
    if (q < J_F1) return E2 + J_F1 + q; q -= J_F1;
    return E3 + J_F2 + q;
}

__device__ __forceinline__ void norm_row_finish(const f32x4 (&v)[4], const f32x4 (&g)[4], const f32x4 (&sc)[4], const f32x4 (&sh)[4], bf16_t* hrow, int lane) {
    float ss = 0.f;
#pragma unroll
    for (int i = 0; i < 4; ++i) ss += v[i][0] * v[i][0] + v[i][1] * v[i][1] + v[i][2] * v[i][2] + v[i][3] * v[i][3];
    ss = red64(ss);
    const float rs = rsqrtf(ss * (1.0f / 1024.0f) + 1e-6f);
#pragma unroll
    for (int i = 0; i < 4; ++i) { const int c = i * 256 + lane * 4; f32x4 y;
#pragma unroll
        for (int j = 0; j < 4; ++j) y[j] = (v[i][j] * rs) * g[i][j] * (1.0f + sc[i][j]) + sh[i][j];
        u32x2 w; w.x = cvt_pk_bf16(y[0], y[1]); w.y = cvt_pk_bf16(y[2], y[3]);
        *(u32x2*)(hrow + c) = w; }
}
__device__ void norm_phase(const float* xin, bf16_t* hout, const float* gain, const float* modl, int sh_off, int sc_off) {
    const int tid_ = otid(); const int wave = tid_ >> 6, lane = tid_ & 63;
    const int S = gridDim.x * 8;
    f32x4 g[4];
#pragma unroll
    for (int i = 0; i < 4; ++i) g[i] = *(const f32x4*)(gain + i * 256 + lane * 4);
    for (int row = blockIdx.x * 8 + wave; row < M; row += 2 * S) {
        const int rowb = row + S; const bool hb = rowb < M; const int rb = hb ? rowb : row;
        const float* xa = xin + (size_t)row * D; const float* xb = xin + (size_t)rb * D;
        const float* ma = modl + (size_t)(row >> 11) * 6144; const float* mb = modl + (size_t)(rb >> 11) * 6144;
        f32x4 va[4], vb[4], sca[4], sha[4], scb[4], shb[4];
#pragma unroll
        for (int i = 0; i < 4; ++i) { const int c = i * 256 + lane * 4; va[i] = *(const f32x4*)(xa + c); vb[i] = *(const f32x4*)(xb + c);
            sca[i] = *(const f32x4*)(ma + sc_off + c); sha[i] = *(const f32x4*)(ma + sh_off + c); scb[i] = *(const f32x4*)(mb + sc_off + c); shb[i] = *(const f32x4*)(mb + sh_off + c); }
        norm_row_finish(va, g, sca, sha, hout + (size_t)row * D, lane);
        if (hb) norm_row_finish(vb, g, scb, shb, hout + (size_t)rowb * D, lane);
    }
}
__device__ void final_norm_phase(float* x, const float* gain) {
    const int tid_ = otid(); const int wave = tid_ >> 6, lane = tid_ & 63;
    f32x4 g[4];
#pragma unroll
    for (int i = 0; i < 4; ++i) g[i] = *(const f32x4*)(gain + i * 256 + lane * 4);
    for (int grp = blockIdx.x * 8 + wave; grp < M / 8; grp += gridDim.x * 8) {
        const int row0 = grp * 8;
#pragma unroll 1
        for (int half = 0; half < 2; ++half) {
            f32x4 v[4][4];
#pragma unroll
            for (int r = 0; r < 4; ++r)
#pragma unroll
                for (int i = 0; i < 4; ++i) v[r][i] = *(const f32x4*)(x + (size_t)(row0 + half * 4 + r) * D + i * 256 + lane * 4);
#pragma unroll
            for (int r = 0; r < 4; ++r) { float ss = 0.f;
#pragma unroll
                for (int i = 0; i < 4; ++i) ss += v[r][i][0] * v[r][i][0] + v[r][i][1] * v[r][i][1] + v[r][i][2] * v[r][i][2] + v[r][i][3] * v[r][i][3];
                ss = red64(ss);
                const float rs = rsqrtf(ss * (1.0f / 1024.0f) + 1e-6f);
                float* xr = x + (size_t)(row0 + half * 4 + r) * D;
#pragma unroll
                for (int i = 0; i < 4; ++i) { f32x4 y;
#pragma unroll
                    for (int j = 0; j < 4; ++j) y[j] = (v[r][i][j] * rs) * g[i][j];
                    *(f32x4*)(xr + i * 256 + lane * 4) = y; } }
        }
    }
}

__device__ void lo_prep_phase(KParamsPtr p, int l) {
    const int tid = otid();
    const bf16_t* proj = (const bf16_t*)(p->ws + WS_PROJ); bf16_t* loa = (bf16_t*)(p->ws + WS_LOA);
    const int stride = gridDim.x * 512;
    constexpr int NBAT = 5;
    for (int base = blockIdx.x * 512 + tid; base < M * 36; base += NBAT * stride) {
        u32x4 rc4[NBAT], rp4[NBAT]; f32x4 m0[NBAT], m1[NBAT];
#pragma unroll
        for (int i = 0; i < NBAT; ++i) { const int idx = base + i * stride; rc4[i] = (u32x4){0u, 0u, 0u, 0u}; rp4[i] = rc4[i]; m0[i] = (f32x4){0.f, 0.f, 0.f, 0.f}; m1[i] = m0[i];
            if (idx < M * 36) { const int row = idx / 36, q8 = (idx - row * 36) * 8;
                if (q8 < 256 || l > 0) {
                    const int col = q8 < 256 ? 3072 + q8 : OFF_VLO + (q8 - 256);
                    const float* mup = q8 < 256 ? p->mu_shift + l * 3328 + 3072 + q8 : p->mu_vres + (q8 - 256);
                    m0[i] = *(const f32x4*)mup; m1[i] = *(const f32x4*)(mup + 4);
                    const bf16_t* src = proj + (size_t)row * LDP + col;
                    rc4[i] = *(const u32x4*)src;
                    if ((row & (T - 1)) != 0) rp4[i] = *(const u32x4*)(src - LDP); } } }
#pragma unroll
        for (int i = 0; i < NBAT; ++i) { const int idx = base + i * stride;
            if (idx < M * 36) { const int row = idx / 36, q8 = (idx - row * 36) * 8;
                u32x4 w = (u32x4){0u, 0u, 0u, 0u};
                if (q8 < 256 || l > 0) {
                    f32x4 c0 = (f32x4){bflo(rc4[i].x), bfhi(rc4[i].x), bflo(rc4[i].y), bfhi(rc4[i].y)}, c1 = (f32x4){bflo(rc4[i].z), bfhi(rc4[i].z), bflo(rc4[i].w), bfhi(rc4[i].w)};
                    const f32x4 p0 = (f32x4){bflo(rp4[i].x), bfhi(rp4[i].x), bflo(rp4[i].y), bfhi(rp4[i].y)}, p1 = (f32x4){bflo(rp4[i].z), bfhi(rp4[i].z), bflo(rp4[i].w), bfhi(rp4[i].w)};
                    c0 = c0 + (p0 - c0) * m0[i]; c1 = c1 + (p1 - c1) * m1[i];
                    if (q8 < 64) {
#pragma unroll
                        for (int j = 0; j < 4; ++j) { c0[j] = 1.0f - 2.0f * __builtin_amdgcn_rcpf(__expf(2.0f * c0[j]) + 1.0f); c1[j] = 1.0f - 2.0f * __builtin_amdgcn_rcpf(__expf(2.0f * c1[j]) + 1.0f); } }
                    else if (q8 >= 128 && q8 < 256) {
#pragma unroll
                        for (int j = 0; j < 4; ++j) { c0[j] = sigm(c0[j]); c1[j] = sigm(c1[j]); } }
                    w.x = cvt_pk_bf16(c0[0], c0[1]); w.y = cvt_pk_bf16(c0[2], c0[3]); w.z = cvt_pk_bf16(c1[0], c1[1]); w.w = cvt_pk_bf16(c1[2], c1[3]);
                }
                *(u32x4*)(loa + (size_t)row * 288 + q8) = w; } }
    }
}

__device__ __forceinline__ void lds_barrier() { asm volatile("s_waitcnt lgkmcnt(0)\n\ts_barrier" ::: "memory"); }

constexpr int TC = 32;
constexpr int LOSB = 296;
constexpr int LB_LO = 0, LB_PRE = LB_LO + TC * LOSB * 2, LB_OPS = LB_PRE + 4 * TC * 64 * 4, LB_Y = LB_OPS + 6 * TC * 64 * 4, LB_CONST = LB_Y + TC * 64 * 4, LB_MU = LB_CONST + 8 * 64 * 4, LB_BON = LB_MU + 480 * 4;
constexpr int CS = 72, CS2 = 40;
constexpr int IMG_AT = 0, IMG_RT = IMG_AT + 16 * CS * 2, IMG_BT = IMG_RT + 16 * CS * 2, IMG_KT = IMG_BT + 16 * CS * 2, IMG_BKT = IMG_KT + 16 * CS * 2,
              IMG_UVT = IMG_BKT + 64 * CS2 * 2, IMG_A2 = IMG_UVT + 64 * CS2 * 2, IMG_A3 = IMG_A2 + 16 * CS2 * 2, IMG_LF = IMG_A3 + 16 * CS2 * 2, IMG_PV = IMG_LF + 16 * 16 * 4, IMG_SIZE = IMG_PV + 64 * 4;
static_assert(2 * IMG_SIZE <= 6 * TC * 64 * 4, "two image sets must fit the operand-array region");
constexpr int LB_CLW = 0;
constexpr int LB_S0B = LB_BON, LB_BFR = LB_S0B + 64 * CS * 2, LB_RHS = LB_BFR + 9 * 4 * 64 * 16, LB_END = LB_RHS + 16 * 64 * 4;
static_assert(LB_END <= LDS_BYTES - 16, "scan LDS (the last 16 bytes hold the grid barrier's set-up words)");

__device__ __forceinline__ f32x4 unpk4(u32x2 w) { return (f32x4){bflo(w.x), bfhi(w.x), bflo(w.y), bfhi(w.y)}; }
__device__ __forceinline__ float tanh_fast(float x) { return 1.0f - 2.0f / (__expf(2.0f * x) + 1.0f); }

__device__ void scan_item(KParamsPtr p, int l, int b, int h, LAS unsigned char* ldsb) {
    const int tid = otid(), wave = tid >> 6, lane = tid & 63;
    const bf16_t* proj = (const bf16_t*)(p->ws + WS_PROJ);
    bf16_t* merged = (bf16_t*)(g_buf + G_MERGED);
    bf16_t* vfirst = (bf16_t*)(g_buf + G_VFIRST);
    const int C0 = h * 64;
    const size_t rowbase = (size_t)b * T;
    LAS float* PRE = (LAS float*)(ldsb + LB_PRE); LAS float* OPS = (LAS float*)(ldsb + LB_OPS); LAS float* Yb = (LAS float*)(ldsb + LB_Y);
    LAS float* CST = (LAS float*)(ldsb + LB_CONST); LAS float* MU = (LAS float*)(ldsb + LB_MU);
    {
        const int kind = tid >> 6, c = tid & 63; float v = 0.f;
        if (kind == 0) v = p->w0[l * 1024 + C0 + c]; else if (kind == 1) v = p->a0[l * 1024 + C0 + c]; else if (kind == 2) v = p->k_k[l * 1024 + C0 + c];
        else if (kind == 3) v = p->k_a[l * 1024 + C0 + c]; else if (kind == 4) v = p->r_k[l * 1024 + C0 + c]; else if (kind == 5) v = p->gn_gain[l * 1024 + C0 + c];
        else if (kind == 6) v = p->gn_bias[l * 1024 + C0 + c]; else v = (l > 0) ? p->v0[C0 + c] : 0.f;
        CST[tid] = v;
        if (tid < 480) { float m;
            if (tid < 256) m = p->mu_shift[l * 3328 + 3072 + tid]; else if (tid < 288) m = (l > 0) ? p->mu_vres[tid - 256] : 0.f;
            else { const int a = (tid - 288) >> 6, c2 = (tid - 288) & 63; m = p->mu_shift[l * 3328 + a * 1024 + C0 + c2]; }
            MU[tid] = m; }
    }
    const int rt = wave >> 2, ct = wave & 3;
    const int ig = (tid >> 4) & 15, jg = tid & 15;
    const int pt = tid >> 4, pc = (tid & 15) * 4;
    const int C = C0 + pc;
    f32x4 accS[4];
#pragma unroll
    for (int x = 0; x < 4; ++x) accS[x] = (f32x4){0.f, 0.f, 0.f, 0.f};
    for (int i = tid; i < 64 * CS * 2 / 4; i += 512) *(LAS unsigned*)(ldsb + LB_S0B + i * 4) = 0u;
    const int r16 = lane & 15, g4 = lane >> 4;
    u32x4 rawc[3]; u32x2 rc, rp, kc, kp, vc, vp, gAw, vfw;
    const bf16_t* loa = (const bf16_t*)(p->ws + WS_LOA);
#define SCAN_PF_LO(t0_) do { \
        _Pragma("unroll") for (int i = 0; i < 3; ++i) { const int idx = tid + 512 * i; rawc[i] = (u32x4){0u, 0u, 0u, 0u}; \
            if (idx < TC * 36) rawc[i] = *(const u32x4*)(loa + (rowbase + (t0_)) * 288 + idx * 8); } } while (0)
#define SCAN_PF_RKV(t0_) do { \
        { const bf16_t* src = proj + (rowbase + (t0_) + pt) * LDP + C; const bool nf = ((t0_) + pt) > 0; const u32x2 z2 = (u32x2){0u, 0u}; \
          rc = *(const u32x2*)src; kc = *(const u32x2*)(src + 1024); vc = *(const u32x2*)(src + 2048); gAw = *(const u32x2*)(src + OFF_GA); \
          rp = nf ? *(const u32x2*)(src - LDP) : z2; kp = nf ? *(const u32x2*)(src - LDP + 1024) : z2; vp = nf ? *(const u32x2*)(src - LDP + 2048) : z2; \
          vfw = z2; if (l > 0) vfw = *(const u32x2*)(vfirst + (rowbase + (t0_) + pt) * 1024 + C); } } while (0)
#define SCAN_LO_COPY() do { _Pragma("unroll") for (int i = 0; i < 3; ++i) { const int idx = tid + 512 * i; \
            if (idx < TC * 36) { const int t = idx / 36, q8 = (idx - t * 36) * 8; *(LAS u32x4*)(ldsb + LB_LO + (t * LOSB + q8) * 2) = rawc[i]; } } } while (0)
#define SCAN_UPPROJ_T(rt, ct) do { f32x4 acc[4]; _Pragma("unroll") for (int k = 0; k < 4; ++k) acc[k] = (f32x4){0.f, 0.f, 0.f, 0.f}; \
            const LAS unsigned char* ap = ldsb + LB_LO + ((rt * 16 + (lane & 15)) * LOSB + (lane >> 4) * 8) * 2; \
            _Pragma("unroll") for (int ks = 0; ks < 9; ++ks) { const int kind = ks < 2 ? 0 : (ks < 4 ? 1 : (ks < 8 ? 2 : 3)); \
                const bf16x8 a = *(const LAS bf16x8*)(ap + ks * 64); const bf16x8 bq = *(const LAS bf16x8*)(ldsb + LB_BFR + ((ks * 4 + ct) * 64 + lane) * 16); \
                acc[kind] = __builtin_amdgcn_mfma_f32_16x16x32_bf16(a, bq, acc[kind], 0, 0, 0); } \
            _Pragma("unroll") for (int k = 0; k < 4; ++k) _Pragma("unroll") for (int r = 0; r < 4; ++r) PRE[(k * TC + rt * 16 + (lane >> 4) * 4 + r) * 64 + ct * 16 + (lane & 15)] = acc[k][r]; } while (0)
#define SCAN_POST(t0_, gg_, bonv_) do { const size_t row = rowbase + (t0_) + pt; \
            const f32x4 y = *(const LAS f32x4*)(Yb + pt * 64 + pc); \
            const f32x4 gng = *(const LAS f32x4*)(CST + 5 * 64 + pc), gnb = *(const LAS f32x4*)(CST + 6 * 64 + pc); \
            const float mean = red16(y[0] + y[1] + y[2] + y[3]) * (1.0f / 64.0f); \
            const f32x4 dv = y - mean; \
            const float var = red16(dv[0] * dv[0] + dv[1] * dv[1] + dv[2] * dv[2] + dv[3] * dv[3]) * (1.0f / 64.0f); \
            const float rstd = rsqrtf(var + 64e-5f); \
            f32x4 o; _Pragma("unroll") for (int j = 0; j < 4; ++j) o[j] = (dv[j] * rstd * gng[j] + gnb[j] + (bonv_)[j]) * (gg_)[j]; \
            u32x2 w; w.x = cvt_pk_bf16(o[0], o[1]); w.y = cvt_pk_bf16(o[2], o[3]); \
            *(u32x2*)(merged + row * 2048 + C) = w; } while (0)
#define SCAN_LW_ROW(row_, pc_) do { const f32x4 aw = *(const LAS f32x4*)(PRE + (0 * TC + (row_)) * 64 + (pc_)) + *(const LAS f32x4*)(CST + 0 * 64 + (pc_)); f32x4 lw; \
            _Pragma("unroll") for (int j = 0; j < 4; ++j) lw[j] = -0.60653065971f * sigm(aw[j]); \
            *(LAS f32x4*)(ldsb + LB_CLW + ((row_) * 64 + (pc_)) * 4) = lw; } while (0)
#define SCAN_CUMSUM(sb_, ct_) do { const int sb = (sb_), ct = (ct_); f32x4 acc = (f32x4){0.f, 0.f, 0.f, 0.f}; float bv[4]; \
            _Pragma("unroll") for (int ks = 0; ks < 4; ++ks) bv[ks] = *(const LAS float*)(ldsb + LB_CLW + ((sb * 16 + g4 + 4 * ks) * 64 + ct * 16 + r16) * 4); \
            _Pragma("unroll") for (int ks = 0; ks < 4; ++ks) acc = __builtin_amdgcn_mfma_f32_16x16x4f32((g4 + 4 * ks <= r16) ? 1.0f : 0.0f, bv[ks], acc, 0, 0, 0); \
            _Pragma("unroll") for (int e = 0; e < 4; ++e) *(LAS float*)(ldsb + LB_CLW + ((sb * 16 + g4 * 4 + e) * 64 + ct * 16 + r16) * 4) = acc[e]; } while (0)
    SCAN_PF_LO(0); SCAN_PF_RKV(0);
    {
        const int ch = C0 + ct * 16 + (lane & 15), q0 = (lane >> 4) * 8;
#pragma unroll
        for (int ki = 0; ki < 5; ++ki) { const int ks = rt + 2 * ki; if (ks < 9) {
            const float* src; int q;
            if (ks < 2) { src = p->w_decay_up + (size_t)l * 64 * 1024; q = ks * 32 + q0; }
            else if (ks < 4) { src = p->w_aaa_up + (size_t)l * 64 * 1024; q = (ks - 2) * 32 + q0; }
            else if (ks < 8) { src = p->w_gate_up + (size_t)l * 128 * 1024; q = (ks - 4) * 32 + q0; }
            else { src = p->w_vres_up; q = q0; }
            float f[8];
#pragma unroll
            for (int j = 0; j < 8; ++j) f[j] = (ks == 8 && l == 0) ? 0.f : src[(size_t)(q + j) * 1024 + ch];
            u32x4 w; w.x = cvt_pk_bf16(f[0], f[1]); w.y = cvt_pk_bf16(f[2], f[3]); w.z = cvt_pk_bf16(f[4], f[5]); w.w = cvt_pk_bf16(f[6], f[7]);
            *(LAS u32x4*)(ldsb + LB_BFR + ((ks * 4 + ct) * 64 + lane) * 16) = w;
        } }
    }
    lds_barrier();
    SCAN_LO_COPY();
    SCAN_PF_LO(TC);
    lds_barrier();
    SCAN_UPPROJ_T(rt, ct);
    lds_barrier();
    SCAN_LW_ROW(pt, pc);
    lds_barrier();
    SCAN_CUMSUM(wave >> 2, wave & 3);
    lds_barrier();
    f32x4 gg = (f32x4){0.f, 0.f, 0.f, 0.f}, bonv = gg;

    for (int chn = 0; chn < T / TC; ++chn) {
        const int t0 = chn * TC;
        if (chn > 0) SCAN_POST(t0 - TC, gg, bonv);
        {
            const size_t row = rowbase + t0 + pt; const int sb = pt >> 4, st = pt & 15;
            LAS unsigned char* img = ldsb + LB_OPS + sb * IMG_SIZE;
            const f32x4 aa = *(const LAS f32x4*)(PRE + (1 * TC + pt) * 64 + pc) + *(const LAS f32x4*)(CST + 1 * 64 + pc);
            const f32x4 ag = *(const LAS f32x4*)(PRE + (2 * TC + pt) * 64 + pc);
            const f32x4 av = *(const LAS f32x4*)(PRE + (3 * TC + pt) * 64 + pc) + *(const LAS f32x4*)(CST + 7 * 64 + pc);
            const f32x4 kkv = *(const LAS f32x4*)(CST + 2 * 64 + pc), kav = *(const LAS f32x4*)(CST + 3 * 64 + pc), rkv = *(const LAS f32x4*)(CST + 4 * 64 + pc);
            const f32x4 mr = *(const LAS f32x4*)(MU + 288 + pc), mk = *(const LAS f32x4*)(MU + 352 + pc), mv = *(const LAS f32x4*)(MU + 416 + pc);
            const f32x4 Lt = *(const LAS f32x4*)(ldsb + LB_CLW + (pt * 64 + pc) * 4);
            f32x4 Lm = (f32x4){0.f, 0.f, 0.f, 0.f};
            if (st > 0) Lm = *(const LAS f32x4*)(ldsb + LB_CLW + ((pt - 1) * 64 + pc) * 4);
#define PR2(w_) ((f32x2){bflo(w_), bfhi(w_)})
#define HF2(v_, h_) ((f32x2){(v_)[2 * (h_)], (v_)[2 * (h_) + 1]})
            f32x2 r2[2], k2v[2], v2[2], a2[2], kk2[2], k22[2]; f32x2 ss2 = (f32x2){0.f, 0.f}, bon2 = (f32x2){0.f, 0.f};
#pragma unroll
            for (int h = 0; h < 2; ++h) {
                const f32x2 rcu = PR2(h ? rc.y : rc.x), rpu = PR2(h ? rp.y : rp.x), kcu = PR2(h ? kc.y : kc.x), kpu = PR2(h ? kp.y : kp.x), vcu = PR2(h ? vc.y : vc.x), vpu = PR2(h ? vp.y : vp.x);
                r2[h] = rcu + (rpu - rcu) * HF2(mr, h); k2v[h] = kcu + (kpu - kcu) * HF2(mk, h); v2[h] = vcu + (vpu - vcu) * HF2(mv, h);
                if (l > 0) { const f32x2 vf = PR2(h ? vfw.y : vfw.x); const f32x2 sg = (f32x2){sigm(av[2 * h]), sigm(av[2 * h + 1])}; v2[h] = v2[h] + (vf - v2[h]) * sg; }
                a2[h] = (f32x2){sigm(aa[2 * h]), sigm(aa[2 * h + 1])};
                kk2[h] = k2v[h] * HF2(kkv, h); ss2 += kk2[h] * kk2[h];
                k22[h] = k2v[h] * ((a2[h] - 1.0f) * HF2(kav, h) + 1.0f);
                bon2 += r2[h] * k22[h] * HF2(rkv, h);
            }
            if (l == 0) { u32x2 w; w.x = cvt_pk_bf16(v2[0].x, v2[0].y); w.y = cvt_pk_bf16(v2[1].x, v2[1].y); *(u32x2*)(vfirst + row * 1024 + C) = w; }
            const float ss = red16(ss2.x + ss2.y), bon = red16(bon2.x + bon2.y);
            const float inv = __builtin_amdgcn_rsqf(fmaxf(ss, 1e-24f));
            u32x2 wa, wr2, wb, wk, wv;
#pragma unroll
            for (int h = 0; h < 2; ++h) {
                const f32x2 kn = kk2[h] * inv;
                const f32x2 ep = (f32x2){__expf(Lt[2 * h]), __expf(Lt[2 * h + 1])}, en = (f32x2){__expf(-Lt[2 * h]), __expf(-Lt[2 * h + 1])}, em = (f32x2){__expf(Lm[2 * h]), __expf(Lm[2 * h + 1])};
                const f32x2 at = -(kn * em), rt2 = r2[h] * ep, bt = kn * a2[h] * en, kt = k22[h] * en;
                if (st == 15) *(LAS f32x2*)(img + IMG_PV + (pc + 2 * h) * 4) = ep;
                const unsigned ua = cvt_pk_bf16(at.x, at.y), ur = cvt_pk_bf16(rt2.x, rt2.y), ub = cvt_pk_bf16(bt.x, bt.y), uk = cvt_pk_bf16(kt.x, kt.y), uv = cvt_pk_bf16(v2[h].x, v2[h].y);
                if (h == 0) { wa.x = ua; wr2.x = ur; wb.x = ub; wk.x = uk; wv.x = uv; } else { wa.y = ua; wr2.y = ur; wb.y = ub; wk.y = uk; wv.y = uv; }
            }
            const f32x4 v4 = (f32x4){v2[0].x, v2[0].y, v2[1].x, v2[1].y};
            const f32x4 gA = unpk4(gAw);
#undef PR2
#undef HF2
            *(LAS u32x2*)(img + IMG_AT + (st * CS + pc) * 2) = wa; *(LAS u32x2*)(img + IMG_RT + (st * CS + pc) * 2) = wr2;
            *(LAS u32x2*)(img + IMG_BT + (st * CS + pc) * 2) = wb; *(LAS u32x2*)(img + IMG_KT + (st * CS + pc) * 2) = wk;
#pragma unroll
            for (int j = 0; j < 4; ++j) { const unsigned xb = j < 2 ? wb.x : wb.y, xk = j < 2 ? wk.x : wk.y, xv = j < 2 ? wv.x : wv.y; const int sh = (j & 1) * 16;
                *(LAS bf16_t*)(img + IMG_BKT + ((pc + j) * CS2 + st) * 2) = (bf16_t)(xb >> sh);
                *(LAS bf16_t*)(img + IMG_BKT + ((pc + j) * CS2 + 16 + st) * 2) = (bf16_t)(xk >> sh);
                *(LAS bf16_t*)(img + IMG_UVT + ((pc + j) * CS2 + 16 + st) * 2) = (bf16_t)(xv >> sh); }
            gg = ag * gA; bonv = bon * v4;
            if (tid < 320) { const int sb2 = tid >= 160, q = tid - sb2 * 160; const int rr2 = q >> 1, hf = (q & 1) * 16; const u32x4 z4 = (u32x4){0u, 0u, 0u, 0u};
                LAS unsigned char* im2 = ldsb + LB_OPS + sb2 * IMG_SIZE;
                if (rr2 < 64) *(LAS u32x4*)(im2 + IMG_UVT + rr2 * CS2 * 2 + hf) = z4; else *(LAS u32x4*)(im2 + IMG_A3 + (rr2 - 64) * CS2 * 2 + hf) = z4; }
        }
        if (chn + 1 < T / TC) SCAN_PF_RKV(t0 + TC);
        lds_barrier();
        {
            const int sb = wave >> 2, pr = wave & 3; LAS unsigned char* img = ldsb + LB_OPS + sb * IMG_SIZE;
            const int fo = (r16 * CS + g4 * 8) * 2;
            const LAS unsigned char* As = img + ((pr & 2) ? IMG_RT : IMG_AT); const LAS unsigned char* Bs = img + ((pr & 1) ? IMG_KT : IMG_BT);
            f32x4 d = (f32x4){0.f, 0.f, 0.f, 0.f};
#pragma unroll
            for (int ks = 0; ks < 2; ++ks) d = __builtin_amdgcn_mfma_f32_16x16x32_bf16(*(const LAS bf16x8*)(As + fo + ks * 64), *(const LAS bf16x8*)(Bs + fo + ks * 64), d, 0, 0, 0);
#pragma unroll
            for (int e = 0; e < 4; ++e) { const int t = g4 * 4 + e, tau = r16;
                if (pr == 0) *(LAS float*)(img + IMG_LF + (t * 16 + tau) * 4) = tau < t ? d[e] : 0.f;
                else { const float val = (pr == 1 ? tau < t : tau <= t) ? d[e] : 0.f; const unsigned wv = cvt_pk_bf16(val, val);
                    const int base = pr == 1 ? IMG_A3 + 32 : (pr == 2 ? IMG_A2 : IMG_A2 + 32);
                    *(LAS bf16_t*)(img + base + (t * CS2 + tau) * 2) = (bf16_t)(wv & 0xffffu); } }
        }
        if (chn + 1 < T / TC) { SCAN_LO_COPY(); if (chn + 2 < T / TC) SCAN_PF_LO(t0 + 2 * TC); }
        lds_barrier();
        if (wave < 2) {
            LAS unsigned char* img = ldsb + LB_OPS + wave * IMG_SIZE;
            float u[16]; int lq[4];
#pragma unroll
            for (int q = 0; q < 4; ++q) lq[q] = *(const LAS int*)(img + IMG_LF + (q * 64 + lane) * 4);
#pragma unroll
            for (int t = 0; t < 16; ++t) u[t] = (t == r16) ? 1.0f : 0.0f;
#pragma unroll
            for (int tau = 0; tau < 15; ++tau)
#pragma unroll
                for (int t = tau + 1; t < 16; ++t) { const int idx = t * 16 + tau; const float lf = __builtin_bit_cast(float, __builtin_amdgcn_readlane(lq[idx >> 6], idx & 63)); u[t] += lf * u[tau]; }
            if (g4 == 0) {
#pragma unroll
                for (int t = 0; t < 16; ++t) *(LAS float*)(img + IMG_LF + (t * 16 + r16) * 4) = u[t]; }
        }
        if (chn + 1 < T / TC) {
            const int ntile = wave < 2 ? 0 : (wave < 4 ? 2 : 1);
#pragma unroll 1
            for (int x = 0; x < ntile; ++x) { const int rtx = x ? 0 : rt, ctx = x ? wave - 2 : ct; SCAN_UPPROJ_T(rtx, ctx); }
        }
        lds_barrier();
        if (wave >= 4) {
            const int cq = wave - 4; const int fo = (r16 * CS + g4 * 8) * 2, so = ((cq * 16 + r16) * CS + g4 * 8) * 2, uo = ((cq * 16 + r16) * CS2 + g4 * 8) * 2;
#pragma unroll 1
            for (int sub = 0; sub < 2; ++sub) {
                LAS unsigned char* img = ldsb + LB_OPS + sub * IMG_SIZE;
                f32x4 acc_y = (f32x4){0.f, 0.f, 0.f, 0.f}, acc_rhs = (f32x4){0.f, 0.f, 0.f, 0.f};
#pragma unroll
                for (int ks = 0; ks < 2; ++ks) { const bf16x8 sbf = *(const LAS bf16x8*)(ldsb + LB_S0B + so + ks * 64);
                    acc_rhs = __builtin_amdgcn_mfma_f32_16x16x32_bf16(*(const LAS bf16x8*)(img + IMG_AT + fo + ks * 64), sbf, acc_rhs, 0, 0, 0);
                    acc_y = __builtin_amdgcn_mfma_f32_16x16x32_bf16(*(const LAS bf16x8*)(img + IMG_RT + fo + ks * 64), sbf, acc_y, 0, 0, 0); }
                acc_rhs = __builtin_amdgcn_mfma_f32_16x16x32_bf16(*(const LAS bf16x8*)(img + IMG_A3 + (r16 * CS2 + g4 * 8) * 2), *(const LAS bf16x8*)(img + IMG_UVT + uo), acc_rhs, 0, 0, 0);
                const f32x4 tf = *(const LAS f32x4*)(img + IMG_LF + (r16 * 16 + g4 * 4) * 4);
                f32x4 uacc = (f32x4){0.f, 0.f, 0.f, 0.f};
#pragma unroll
                for (int ks = 0; ks < 4; ++ks) uacc = __builtin_amdgcn_mfma_f32_16x16x4f32(tf[ks], acc_rhs[ks], uacc, 0, 0, 0);
                u32x2 uw; uw.x = cvt_pk_bf16(uacc[0], uacc[1]); uw.y = cvt_pk_bf16(uacc[2], uacc[3]);
                *(LAS u32x2*)(img + IMG_UVT + ((cq * 16 + r16) * CS2 + g4 * 4) * 2) = uw;
                asm volatile("s_waitcnt lgkmcnt(0)" ::: "memory");
                const bf16x8 ua = *(const LAS bf16x8*)(img + IMG_UVT + uo);
                acc_y = __builtin_amdgcn_mfma_f32_16x16x32_bf16(*(const LAS bf16x8*)(img + IMG_A2 + (r16 * CS2 + g4 * 8) * 2), ua, acc_y, 0, 0, 0);
#pragma unroll
                for (int e = 0; e < 4; ++e) Yb[(sub * 16 + g4 * 4 + e) * 64 + cq * 16 + r16] = acc_y[e];
#pragma unroll
                for (int jt = 0; jt < 4; ++jt) {
                    accS[jt] = __builtin_amdgcn_mfma_f32_16x16x32_bf16(ua, *(const LAS bf16x8*)(img + IMG_BKT + ((jt * 16 + r16) * CS2 + g4 * 8) * 2), accS[jt], 0, 0, 0);
                    const float pj = *(const LAS float*)(img + IMG_PV + (jt * 16 + r16) * 4);
                    accS[jt] = accS[jt] * pj;
#pragma unroll
                    for (int e = 0; e < 4; ++e) { const unsigned wv = cvt_pk_bf16(accS[jt][e], accS[jt][e]);
                        *(LAS bf16_t*)(ldsb + LB_S0B + ((cq * 16 + g4 * 4 + e) * CS + jt * 16 + r16) * 2) = (bf16_t)(wv & 0xffffu); } }
                asm volatile("s_waitcnt lgkmcnt(0)" ::: "memory");
            }
        } else if (chn + 1 < T / TC) {
#pragma unroll
            for (int x = 0; x < 2; ++x) { const int tl = wave * 2 + x, sbn = tl >> 2, ctn = tl & 3;
                SCAN_LW_ROW(sbn * 16 + (lane >> 2), ctn * 16 + (lane & 3) * 4);
                asm volatile("s_waitcnt lgkmcnt(0)" ::: "memory");
                SCAN_CUMSUM(sbn, ctn); }
        }
        lds_barrier();
    }
    SCAN_POST(T - TC, gg, bonv);
#undef SCAN_PF_LO
#undef SCAN_PF_RKV
#undef SCAN_LO_COPY
#undef SCAN_UPPROJ_T
#undef SCAN_POST
#undef SCAN_LW_ROW
#undef SCAN_CUMSUM
    lds_barrier();
}

__device__ void conv_item(KParamsPtr p, int l, int tile, LAS unsigned char* ldsb) {
    const int tid = otid(), wave = tid >> 6, lane = tid & 63;
    const bf16_t* proj = (const bf16_t*)(p->ws + WS_PROJ);
    bf16_t* merged = (bf16_t*)(g_buf + G_MERGED);
    const int b = tile >> 6, t0 = (tile & 63) * 32;
    LAS unsigned* G = (LAS unsigned*)ldsb;
    LAS float* part = (LAS float*)(ldsb + 63 * 2048);
    for (int i = tid; i < 63 * 128; i += 512) { const int r = i >> 7, c16 = i & 127; const int t = t0 - 30 + r;
        u32x4 v = (u32x4){0u, 0u, 0u, 0u};
        if (t >= 0 && r < 62) v = *(const u32x4*)(proj + ((size_t)b * T + t) * LDP + OFF_GLU + c16 * 8);
        *(LAS u32x4*)(ldsb + r * 2048 + c16 * 16) = v; }
    const int c0 = tid * 2;
    unsigned gbw[32];
#pragma unroll
    for (int t = 0; t < 32; ++t) gbw[t] = *(const unsigned*)(proj + ((size_t)b * T + t0 + t) * LDP + OFF_GB + c0);
    lds_barrier();
    float z0[32], z1[32];
    { const f32x2 cb = *(const f32x2*)(p->conv_b + l * 1024 + c0);
#pragma unroll
      for (int t = 0; t < 32; ++t) { z0[t] = cb.x; z1[t] = cb.y; } }
    const float* cw = p->conv_w + (size_t)l * 31 * 1024 + c0;
    f32x2 wc[4], wn[4];
#pragma unroll
    for (int q = 0; q < 4; ++q) wc[q] = *(const f32x2*)(cw + q * 1024);
#pragma unroll 1
    for (int jb = 0; jb < 32; jb += 4) {
#pragma unroll
        for (int q = 0; q < 4; ++q) { const int jn = jb + 4 + q; wn[q] = (f32x2){0.f, 0.f}; if (jn < 31) wn[q] = *(const f32x2*)(cw + jn * 1024); }
        float g0[35], g1[35];
#pragma unroll
        for (int r = 0; r < 35; ++r) { const unsigned gw = G[(jb + r) * 512 + tid]; g0[r] = bflo(gw); g1[r] = bfhi(gw); }
#pragma unroll
        for (int q = 0; q < 4; ++q) {
#pragma unroll
            for (int t = 0; t < 32; ++t) { z0[t] += g0[t + q] * wc[q].x; z1[t] += g1[t + q] * wc[q].y; } }
#pragma unroll
        for (int q = 0; q < 4; ++q) wc[q] = wn[q];
    }
#pragma unroll
    for (int t = 0; t < 32; ++t) { float s1 = z0[t] + z1[t], s2 = z0[t] * z0[t] + z1[t] * z1[t]; s1 = red64(s1); s2 = red64(s2);
        if (lane == 0) { part[(t * 8 + wave) * 2] = s1; part[(t * 8 + wave) * 2 + 1] = s2; } }
    lds_barrier();
    const f32x2 lg = *(const f32x2*)(p->conv_ln_gain + l * 1024 + c0), lb = *(const f32x2*)(p->conv_ln_bias + l * 1024 + c0);
#pragma unroll
    for (int t = 0; t < 32; ++t) { float s1 = 0.f, s2 = 0.f;
#pragma unroll
        for (int w = 0; w < 8; ++w) { s1 += part[(t * 8 + w) * 2]; s2 += part[(t * 8 + w) * 2 + 1]; }
        const float mean = s1 * (1.0f / 1024.0f); const float var = fmaxf(s2 * (1.0f / 1024.0f) - mean * mean, 0.f); const float rstd = rsqrtf(var + 1e-5f);
        const size_t row = (size_t)b * T + t0 + t;
        const unsigned gw = gbw[t];
        float y0 = (z0[t] - mean) * rstd * lg.x + lb.x, y1 = (z1[t] - mean) * rstd * lg.y + lb.y;
        y0 = y0 * sigm(y0) * bflo(gw); y1 = y1 * sigm(y1) * bfhi(gw);
        *(unsigned*)(merged + row * 2048 + 1024 + c0) = cvt_pk_bf16(y0, y1); }
    lds_barrier();
}

__device__ void mixer_phase(KParamsPtr p, int l, LAS unsigned char* ldsb, const bool grp2) {
    const int G = gridDim.x; const int NS = G >= 256 ? 128 : (G / 2 > 0 ? G / 2 : 1);
    int* done = (int*)(p->ws + WS_CTR) + 4 + l;
    if (grp2) {
        asm volatile("s_waitcnt vmcnt(0)" ::: "memory");
        __syncthreads();
        if (otid() == 0) { __builtin_amdgcn_fence(__ATOMIC_RELEASE, "agent"); asm volatile("s_waitcnt vmcnt(0)" ::: "memory"); __hip_atomic_fetch_add(done, 1, __ATOMIC_RELAXED, __HIP_MEMORY_SCOPE_AGENT); }
    }
    if ((int)blockIdx.x < NS) { for (int it = blockIdx.x; it < 128; it += NS) scan_item(p, l, it >> 4, it & 15, ldsb); }
    if (G == 256) {
        if (otid() == 0) { unsigned sp = 0u; while (__hip_atomic_load(done, __ATOMIC_RELAXED, __HIP_MEMORY_SCOPE_AGENT) < 128) { __builtin_amdgcn_s_sleep(4); if (++sp > (1u << 20)) break; }
            __builtin_amdgcn_fence(__ATOMIC_ACQUIRE, "agent"); asm volatile("s_waitcnt vmcnt(0)" ::: "memory"); }
        __syncthreads();
    }
    int* ctr = (int*)(p->ws + WS_CTR) + l; LAS int* slot = (LAS int*)(ldsb + 63 * 2048 + 2048);
    const int tid = otid();
    for (;;) {
        if (tid == 0) *slot = atomicAdd(ctr, 1);
        __syncthreads();
        const int tile = *slot;
        __syncthreads();
        if (tile >= 512) break;
        conv_item(p, l, tile, ldsb);
    }
    {
        int* ctr2 = (int*)(p->ws + WS_CTR) + 2 + l; const int nq = l == 0 ? PREP_B0 : PREP_B1;
        for (;;) {
            if (tid == 0) *slot = atomicAdd(ctr2, 1);
            __syncthreads();
            const int q = *slot;
            __syncthreads();
            if (q >= nq) break;
            prep_job(p, prep_b_job(l, q), (LAS float*)ldsb);
        }
    }
}

#define XB_TMO      128
#define XB_XCNT(j)  (256  + 64 * (j))
#define XB_XSUB(j)  (1280 + 64 * (j))
#define XB_XGEN(j)  (2304 + 64 * (j))
#define XB_TOP      3328
#define XB_TOPGEN   3392
#define XCD_BAR_WORDS 3456
#define XB_SPIN_CAP (1u << 18)

__device__ __forceinline__ unsigned xb_ld(unsigned* p)              { return __hip_atomic_load(p, __ATOMIC_RELAXED, __HIP_MEMORY_SCOPE_AGENT); }
__device__ __forceinline__ unsigned xb_add(unsigned* p, unsigned v) { return __hip_atomic_fetch_add(p, v, __ATOMIC_RELAXED, __HIP_MEMORY_SCOPE_AGENT); }
__device__ __forceinline__ unsigned xb_xcc_id() { return (unsigned)__builtin_amdgcn_s_getreg((3 << 11) | 20) & 0xFu; }
#define XB_SPIN(cond, bar) do { unsigned _sp = 0; while (cond) { __builtin_amdgcn_s_sleep(1); \
    if ((++_sp & 255u) == 0u) { if (xb_ld(&(bar)[XB_TMO])) break; if (_sp > XB_SPIN_CAP) { atomicAdd(&(bar)[XB_TMO], 1u); break; } } } } while (0)

struct XcdBarrier {
    unsigned* bar; unsigned x;
    volatile LAS unsigned* st;
};

__device__ __forceinline__ XcdBarrier xcd_barrier_post(unsigned* bar, volatile LAS unsigned* st) {
    XcdBarrier b; b.bar = bar; b.x = xb_xcc_id(); b.st = st;
    if (threadIdx.x == 0) (void)xb_add(&bar[XB_XCNT(b.x)], 1u);
    return b;
}
__device__ __forceinline__ void xcd_barrier_complete(unsigned* bar, unsigned x, unsigned& nloc, unsigned& nx) {
    const unsigned G = gridDim.x * gridDim.y * gridDim.z;
    unsigned sum, cnt, mine, sp = 0u;
    for (;;) {
        sum = 0u; cnt = 0u; mine = 0u;
#pragma unroll
        for (unsigned j = 0; j < 16; ++j) { const unsigned c = xb_ld(&bar[XB_XCNT(j)]); sum += c; cnt += (c > 0u) ? 1u : 0u; mine = (j == x) ? c : mine; }
        if (sum == G) break;
        __builtin_amdgcn_s_sleep(1);
        if ((++sp & 255u) == 0u) { if (xb_ld(&bar[XB_TMO])) break; if (sp > XB_SPIN_CAP) { atomicAdd(&bar[XB_TMO], 1u); break; } }
    }
    nloc = mine > 0u ? mine : 1u; nx = cnt > 0u ? cnt : 1u;
}

__device__ __forceinline__ void xcd_barrier(const XcdBarrier& b) {
    asm volatile("s_waitcnt vmcnt(0)" ::: "memory");
    __syncthreads();
    if (threadIdx.x == 0) {
        unsigned* bar = b.bar;
        __builtin_amdgcn_s_waitcnt(0);
        unsigned nloc = b.st[0], nx = b.st[1];
        if (nloc == 0u) { xcd_barrier_complete(bar, b.x, nloc, nx); b.st[0] = nloc; b.st[1] = nx; }
        const unsigned old = xb_add(&bar[XB_XSUB(b.x)], 1u);
        const unsigned gen = old / nloc;
        if (old + 1u == (gen + 1u) * nloc) {
            __builtin_amdgcn_fence(__ATOMIC_RELEASE, "agent");
            asm volatile("s_waitcnt vmcnt(0)" ::: "memory");
            const unsigned og = xb_add(&bar[XB_TOP], 1u);
            const unsigned tg = og / nx;
            if (og + 1u == (tg + 1u) * nx) xb_add(&bar[XB_TOPGEN], 1u);
            else XB_SPIN(xb_ld(&bar[XB_TOPGEN]) == tg, bar);
            __builtin_amdgcn_fence(__ATOMIC_ACQUIRE, "agent");
            xb_add(&bar[XB_XGEN(b.x)], 1u);
            asm volatile("s_waitcnt vmcnt(0)" ::: "memory");
        } else {
            XB_SPIN(xb_ld(&bar[XB_XGEN(b.x)]) == gen, bar);
            __builtin_amdgcn_fence(__ATOMIC_ACQUIRE, "agent");
            asm volatile("s_waitcnt vmcnt(0)" ::: "memory");
        }
    }
    __syncthreads();
}

static_assert(XCD_BAR_WORDS * 4 <= 16384, "barrier words");

constexpr int NPHASE = 20;
__global__ void __launch_bounds__(512, 2) mega(Params p_unused, int ph_lo, int ph_hi) {
    extern __shared__ __attribute__((aligned(16))) unsigned char shm[];
    LAS unsigned char* lds = (LAS unsigned char*)shm;
    cg::grid_group grid = cg::this_grid();
    volatile LAS unsigned* bst = (volatile LAS unsigned*)(lds + LDS_BYTES - 16);
    if (threadIdx.x == 0) { bst[0] = 0u; bst[1] = 0u; }
    __syncthreads();
    XcdBarrier gbar;
    { KParamsPtr p0 = (KParamsPtr)__builtin_amdgcn_kernarg_segment_ptr(); gbar = xcd_barrier_post((unsigned*)(p0->ws + WS_BAR), bst); }
    for (int ph = ph_lo; ph < ph_hi; ++ph) {
        KParamsPtr p = (KParamsPtr)__builtin_amdgcn_kernarg_segment_ptr();
        asm volatile("" : "+s"(p));
        bf16_t* proj = (bf16_t*)(p->ws + WS_PROJ); bf16_t* hbuf = (bf16_t*)(p->ws + WS_H); float* mod = (float*)(p->ws + WS_MOD);
        bf16_t* merged = (bf16_t*)(g_buf + G_MERGED);
        if (ph == 0) prep_phase(p, (LAS float*)lds);
        else if (ph == NPHASE - 1) final_norm_phase(p->out, p->final_gain);
        else {
            const int l = (ph - 1) / 9, s = (ph - 1) % 9;
            const float* modl = mod + (size_t)l * 8 * 6144;
            const float* xcur = (l == 0) ? p->x : p->out;
            if (s == 0) norm_phase(xcur, hbuf, p->norm_mix_gain + l * 1024, modl, 0, 1024);
            else if (s == 2) lo_prep_phase(p, l);
            else if (s == 4) mixer_phase(p, l, lds, gridDim.x == 256 && blockIdx.x >= 128);
            else if (s == 6) norm_phase(p->out, hbuf, p->norm_ffn_gain + l * 1024, modl, 3072, 4096);
            else {
                pg8::Gemm g; pg8::Epi E; g.M = M; E.pn0 = 0; E.lv = l; int Gq = gridDim.x, cq = blockIdx.x; const bool split = gridDim.x == 256;
                if (s == 1) { g.A = hbuf; g.Bt = (const bf16_t*)(g_buf + G_WIN) + (size_t)l * 7680 * 1024; g.N = (split ? 17 + l : 29 + l) * 256; g.K = 1024; E.kind = 0; E.O = proj; E.xin = nullptr; E.xout = nullptr; E.gate = nullptr; }
                else if (s == 3) { g.A = hbuf; g.Bt = (const bf16_t*)(g_buf + G_WIN) + (size_t)l * 7680 * 1024 + (size_t)(17 + l) * 256 * 1024; g.N = 12 * 256; g.K = 1024; E.kind = 0; E.O = proj; E.xin = nullptr; E.xout = nullptr; E.gate = nullptr; E.pn0 = 17 + l;
                    Gq = 128; cq = (split && blockIdx.x >= 128) ? (int)blockIdx.x - 128 : (1 << 20); }
                else if (s == 5) { g.A = merged; g.Bt = (const bf16_t*)(g_buf + G_WOUT) + (size_t)l * 1024 * 2048; g.N = 1024; g.K = 2048; E.kind = 2; E.O = nullptr; E.xin = xcur; E.xout = p->out; E.gate = modl + 2048; }
                else if (s == 7) { g.A = hbuf; g.Bt = (const bf16_t*)(g_buf + G_WF1) + (size_t)l * 4096 * 1024; g.N = 4096; g.K = 1024; E.kind = 1; E.O = proj; E.xin = nullptr; E.xout = nullptr; E.gate = nullptr; }
                else { g.A = proj; g.Bt = (const bf16_t*)(g_buf + G_WF2) + (size_t)l * 1024 * 4096; g.N = 1024; g.K = 4096; E.kind = 2; E.O = nullptr; E.xin = p->out; E.xout = p->out; E.gate = modl + 5120; }
                pg8::StaticOrder S; S.init(M, g.N, Gq, cq);
                pg8::gemm_phase(lds, g, S, E);
            }
        }
        if (ph + 1 < ph_hi && !(ph > 0 && ph < NPHASE - 1 && (ph - 1) % 9 == 3)) { if (ph_hi > NPHASE) grid.sync(); else xcd_barrier(gbar); }
    }
}

extern "C" void kernel_launch(void* const* d_in, const int* in_sizes, int n_in, void* d_out, int out_size, void* d_ws, size_t ws_size, hipStream_t stream) {
    static int grid = 0;
    if (grid == 0) {
        if (n_in != 30 || out_size != M * D || ws_size < WS_END) { fprintf(stderr, "kernel_launch: unexpected shapes (n_in %d out %d ws %zu need %zu)\n", n_in, out_size, ws_size, (size_t)WS_END); grid = -1; return; }
        int dev = 0, cus = 0, per_cu = 0;
        hipGetDevice(&dev); hipDeviceGetAttribute(&cus, hipDeviceAttributeMultiprocessorCount, dev);
        if (hipFuncSetAttribute((const void*)mega, hipFuncAttributeMaxDynamicSharedMemorySize, LDS_BYTES) != hipSuccess) { fprintf(stderr, "kernel_launch: hipFuncSetAttribute failed\n"); grid = -1; return; }
        if (hipOccupancyMaxActiveBlocksPerMultiprocessor(&per_cu, (const void*)mega, 512, LDS_BYTES) != hipSuccess || per_cu < 1) { fprintf(stderr, "kernel_launch: occupancy query gave %d\n", per_cu); per_cu = 1; }
        (void)hipGetLastError();
        grid = cus * per_cu;
        if (grid > 256) grid = 256;
    }
    if (grid < 0) return;
    Params p{};
    const float** pp = (const float**)&p;
    for (int i = 0; i < 30; ++i) pp[i] = (const float*)d_in[i];
    p.out = (float*)d_out; p.ws = (unsigned char*)d_ws;
#if MULTI_LAUNCH
    for (int ph = 0; ph < NPHASE; ++ph) hipLaunchKernelGGL(mega, dim3(grid), dim3(512), LDS_BYTES, stream, p, ph, ph + 1);
#else
    if (hipMemsetAsync((char*)d_ws + WS_BAR, 0, 16384, stream) != hipSuccess) { fprintf(stderr, "kernel_launch: memset of the barrier words failed\n"); return; }
    int lo = 0, hi = NPHASE;
    void* args[] = {&p, &lo, &hi};
    hipError_t e = hipLaunchCooperativeKernel((const void*)mega, dim3(grid), dim3(512), args, LDS_BYTES, stream);
    if (e != hipSuccess) fprintf(stderr, "cooperative launch failed: %s (grid %d)\n", hipGetErrorString(e), grid);
#endif
}
```

```cpp
#include <hip/hip_runtime.h>
#include <hip/hip_cooperative_groups.h>
#include <cstdio>
namespace cg = cooperative_groups;

#ifndef MULTI_LAUNCH
#define MULTI_LAUNCH 0
#endif

#define LAS __attribute__((address_space(3)))
typedef unsigned short bf16_t;
typedef short bf16x8 __attribute__((ext_vector_type(8)));
typedef float f32x4 __attribute__((ext_vector_type(4)));
typedef float f32x2 __attribute__((ext_vector_type(2)));
typedef unsigned u32x4 __attribute__((ext_vector_type(4)));
typedef unsigned u32x2 __attribute__((ext_vector_type(2)));

constexpr int NB = 8, T = 2048, D = 1024, M = NB * T, NH = 16, DFF = 4096;
constexpr int NCOLS = 7424, NP0 = 7424, NP1 = 7680, LDP = 6656;
constexpr int OFF_GLU = 3328, OFF_GA = 4352, OFF_GB = 5376, OFF_VLO = 6400;
constexpr int LDS_BYTES = 163840;

constexpr size_t WS_PROJ = 0;
constexpr size_t WS_H    = (size_t)M * LDP * 2;
constexpr size_t WS_MOD  = WS_H + (size_t)M * D * 2;
constexpr size_t WS_CTR  = WS_MOD + 2 * 8 * 6144 * 4;
constexpr size_t WS_LOA  = WS_CTR + 256;
constexpr size_t WS_BAR  = WS_LOA + (size_t)M * 288 * 2;
constexpr size_t WS_END  = WS_BAR + 16384;
constexpr size_t G_MERGED = 0;
constexpr size_t G_VFIRST = G_MERGED + (size_t)M * 2048 * 2;
constexpr size_t G_WIN    = G_VFIRST + (size_t)M * 1024 * 2;
constexpr size_t G_WOUT   = G_WIN + (size_t)2 * 7680 * 1024 * 2;
constexpr size_t G_WF1    = G_WOUT + (size_t)2 * 1024 * 2048 * 2;
constexpr size_t G_WF2    = G_WF1 + (size_t)2 * 4096 * 1024 * 2;
constexpr size_t G_END    = G_WF2 + (size_t)2 * 1024 * 4096 * 2;
__device__ __attribute__((aligned(256))) unsigned char g_buf[G_END];

struct Params {
    const float *x, *c, *norm_mix_gain, *norm_ffn_gain, *ada_w, *ada_b, *w_in, *w_in_vres, *mu_shift, *mu_vres,
        *w0, *w_decay_up, *a0, *w_aaa_up, *w_gate_up, *k_k, *k_a, *r_k, *gn_gain, *gn_bias, *v0, *w_vres_up,
        *conv_w, *conv_b, *conv_ln_gain, *conv_ln_bias, *w_out, *w_ff_in, *w_ff_out, *final_gain;
    float* out; unsigned char* ws;
};
#if defined(__HIP_DEVICE_COMPILE__)
typedef const __attribute__((address_space(4))) Params* KParamsPtr;
#else
typedef const Params* KParamsPtr;
#endif

__device__ __forceinline__ int otid() { int t = threadIdx.x; asm volatile("" : "+v"(t)); return t; }
__device__ __forceinline__ int obid() { int t = blockIdx.x; asm volatile("" : "+s"(t)); return t; }
__device__ __forceinline__ float bf2f(bf16_t v) { return __uint_as_float(((unsigned)v) << 16); }
__device__ __forceinline__ float bflo(unsigned w) { return __uint_as_float(w << 16); }
__device__ __forceinline__ float bfhi(unsigned w) { return __uint_as_float(w & 0xffff0000u); }
__device__ __forceinline__ unsigned cvt_pk_bf16(float lo, float hi) { unsigned r; asm volatile("v_cvt_pk_bf16_f32 %0, %1, %2" : "=v"(r) : "v"(lo), "v"(hi)); return r; }
__device__ __forceinline__ float sigm(float x) { return __builtin_amdgcn_rcpf(1.0f + __expf(-x)); }
template <int CTRL> __device__ __forceinline__ float dppf(float x) { return __builtin_bit_cast(float, __builtin_amdgcn_update_dpp(0, __builtin_bit_cast(int, x), CTRL, 0xF, 0xF, false)); }
__device__ __forceinline__ float red16(float x) { x += dppf<0xB1>(x); x += dppf<0x4E>(x); x += dppf<0x124>(x); x += dppf<0x128>(x); return x; }
__device__ __forceinline__ float red64(float x) { x = red16(x); x += __shfl_xor(x, 16); x += __shfl_xor(x, 32); return x; }

namespace pg8 {
constexpr int BM = 256, BK = 64, HALF = 128, HTB = HALF * BK * 2, STAGE_BYTES = 8 * HTB, NXCD = 8, WGM = 8;
__host__ __device__ __forceinline__ int lds_byte(int r, int c) { const int st = (r >> 4) * 2 + (c >> 5), rr = r & 15, cc = c & 31, ob = rr * 64 + cc * 2; return st * 1024 + (ob ^ (((ob >> 9) & 1) << 5)); }
__host__ __device__ __forceinline__ void stage_rc(int b, int& R, int& C) { const int st = b / 1024, sb = b % 1024, swz = sb ^ (((sb >> 9) & 1) << 5); R = (st >> 1) * 16 + swz / 64; C = (st & 1) * 32 + (swz % 64) / 2; }
__host__ __device__ __forceinline__ int perm32(int rho) { const int n = rho >> 4, i = rho & 15; return 8 * (i >> 2) + 4 * n + (i & 3); }
struct Unit { int pm, pn; };
struct Gemm { const bf16_t* A; const bf16_t* Bt; int M, N, K; };
struct StaticOrder {
    int nM, nN, nwg, G, c;
    __device__ void init(int M_, int N_, int G_, int c_) { nM = M_ / BM; nN = N_ / BM; nwg = nM * nN; G = G_; c = c_; }
    __device__ bool next(int i, Unit& u) const {
        const long L = (long)i * G + c; if (L >= nwg) return false;
        int wgid = (int)L; { const int q = nwg / NXCD, r = nwg % NXCD, xcd = wgid % NXCD, off = wgid / NXCD; wgid = (xcd < r ? xcd * (q + 1) : r * (q + 1) + (xcd - r) * q) + off; }
        const int nig = WGM * nN, gid = wgid / nig, fm = gid * WGM, gsz = (nM - fm) < WGM ? (nM - fm) : WGM;
        u.pm = fm + ((wgid % nig) % gsz); u.pn = (wgid % nig) / gsz; return true;
    }
};

template <class Epi>
__device__ __forceinline__ void gemm_phase(LAS unsigned char* lds, const Gemm g, const StaticOrder& S, const Epi& E) {
    const int tid = otid(), wid = __builtin_amdgcn_readfirstlane(tid >> 6), lane = tid & 63, wr = wid >> 2, wc = wid & 3, fr = lane & 15, fq = lane >> 4;
    const int K = g.K, nt = K / BK;
    unsigned voffA[2], voffB[2];
#pragma unroll
    for (int i = 0; i < 2; ++i) { int R, C; stage_rc(tid * 16 + i * 8192, R, C); const int Rb = Epi::PERM ? ((R & ~31) + perm32(R & 31)) : R;
        voffA[i] = (unsigned)(R * K + C) * 2u; voffB[i] = (unsigned)(Rb * K + C) * 2u; }
    const size_t kstep = (size_t)(BK * 2);
    const size_t hstep = (size_t)HALF * K * 2;
    const size_t tstep = 2 * hstep;
    const unsigned ldsw = (unsigned)wid * 1024u;
    const int aoff = lds_byte(wr * 64 + fr, fq * 8), boff = lds_byte(wc * 32 + fr, fq * 8);
#define PG8_SA(b, h) (((b) * 2 + (h)) * HTB)
#define PG8_SB(b, h) ((4 + (b) * 2 + (h)) * HTB)
#define PG8_STAGE(bufoff, gbase, voff) do { _Pragma("unroll") for (int _i = 0; _i < 2; ++_i) \
        __builtin_amdgcn_global_load_lds((const unsigned*)((const char*)(gbase) + (voff)[_i]), (LAS unsigned*)(lds + (bufoff) + ldsw + _i * 8192), 16, 0, 0); } while (0)
#define PG8_LDA(dst, b, h) do { _Pragma("unroll") for (int m = 0; m < 4; ++m) _Pragma("unroll") for (int k = 0; k < 2; ++k) dst[m][k] = *(const LAS bf16x8*)(lds + PG8_SA(b, h) + aoff + m * 2048 + k * 1024); } while (0)
#define PG8_LDB(dst, b, h) do { _Pragma("unroll") for (int n = 0; n < 2; ++n) _Pragma("unroll") for (int k = 0; k < 2; ++k) dst[n][k] = *(const LAS bf16x8*)(lds + PG8_SB(b, h) + boff + n * 2048 + k * 1024); } while (0)
#define PG8_MMA(ai, bj, At, Bt) do { __builtin_amdgcn_s_setprio(1); _Pragma("unroll") for (int m = 0; m < 4; ++m) _Pragma("unroll") for (int n = 0; n < 2; ++n) _Pragma("unroll") for (int k = 0; k < 2; ++k) \
        acc[ai][bj][m][n] = __builtin_amdgcn_mfma_f32_16x16x32_bf16(Bt[n][k], At[m][k], acc[ai][bj][m][n], 0, 0, 0); __builtin_amdgcn_s_setprio(0); } while (0)
#define PG8_WAIT_V(n) asm volatile("s_waitcnt vmcnt(" #n ")" ::: "memory")
#define PG8_WAIT_L(n) asm volatile("s_waitcnt lgkmcnt(" #n ")" ::: "memory")
#define PG8_BAR __builtin_amdgcn_s_barrier()
#define PG8_SCHED __builtin_amdgcn_sched_barrier(0)
    Unit cur, nxt; int ui = 0;
    if (!S.next(0, cur)) return;
    f32x4 acc[2][2][4][2];
#pragma unroll
    for (int a = 0; a < 2; ++a)
#pragma unroll
        for (int b = 0; b < 2; ++b)
#pragma unroll
            for (int m = 0; m < 4; ++m)
#pragma unroll
                for (int n = 0; n < 2; ++n) acc[a][b][m][n] = (f32x4){0.f, 0.f, 0.f, 0.f};
    bf16x8 At[4][2], B0[2][2], B1[2][2];
    const char* cA = (const char*)g.A + (size_t)cur.pm * tstep; const char* cB = (const char*)g.Bt + (size_t)cur.pn * tstep;
    PG8_STAGE(PG8_SB(0, 0), cB, voffB); PG8_STAGE(PG8_SA(0, 0), cA, voffA); PG8_STAGE(PG8_SB(0, 1), cB + hstep, voffB); PG8_STAGE(PG8_SA(0, 1), cA + hstep, voffA);
    if (wr == 1) PG8_BAR;
    PG8_WAIT_V(4); PG8_BAR;
    PG8_STAGE(PG8_SB(1, 0), cB + kstep, voffB); PG8_STAGE(PG8_SA(1, 0), cA + kstep, voffA); PG8_STAGE(PG8_SB(1, 1), cB + hstep + kstep, voffB);
    PG8_WAIT_V(6); PG8_BAR;
    for (;;) {
        const bool has_next = S.next(ui + 1, nxt);
        const char* nA = has_next ? (const char*)g.A + (size_t)nxt.pm * tstep : cA; const char* nB = has_next ? (const char*)g.Bt + (size_t)nxt.pn * tstep : cB;
        for (int t = 0; t < nt; t += 2) {
            const bool last = (t == nt - 2);
            const char* a1 = cA + (size_t)(t + 1) * kstep;
            const char* a2 = last ? nA : cA + (size_t)(t + 2) * kstep; const char* b2 = last ? nB : cB + (size_t)(t + 2) * kstep;
            const char* a3 = a2 + kstep; const char* b3 = b2 + kstep;
            PG8_LDB(B0, 0, 0); PG8_SCHED; PG8_LDA(At, 0, 0); PG8_STAGE(PG8_SA(1, 1), a1 + hstep, voffA);
            PG8_WAIT_L(8); PG8_BAR; PG8_WAIT_L(0); PG8_MMA(0, 0, At, B0); PG8_BAR; PG8_SCHED;
            PG8_LDB(B1, 0, 1); PG8_STAGE(PG8_SB(0, 0), b2, voffB);
            PG8_BAR; PG8_WAIT_L(0); PG8_MMA(0, 1, At, B1); PG8_BAR;
            PG8_LDA(At, 0, 1); PG8_STAGE(PG8_SA(0, 0), a2, voffA);
            PG8_BAR; PG8_WAIT_L(0); PG8_MMA(1, 0, At, B0); PG8_BAR; PG8_SCHED;
            PG8_STAGE(PG8_SB(0, 1), b2 + hstep, voffB);
            PG8_WAIT_V(6); PG8_BAR; PG8_MMA(1, 1, At, B1); PG8_BAR;
            PG8_LDB(B0, 1, 0); PG8_SCHED; PG8_LDA(At, 1, 0); PG8_STAGE(PG8_SA(0, 1), a2 + hstep, voffA);
            PG8_WAIT_L(8); PG8_BAR; PG8_WAIT_L(0); PG8_MMA(0, 0, At, B0); PG8_BAR; PG8_SCHED;
            PG8_LDB(B1, 1, 1); PG8_STAGE(PG8_SB(1, 0), b3, voffB);
            PG8_BAR; PG8_WAIT_L(0); PG8_MMA(0, 1, At, B1); PG8_BAR;
            PG8_LDA(At, 1, 1); PG8_STAGE(PG8_SA(1, 0), a3, voffA);
            PG8_BAR; PG8_WAIT_L(0); PG8_MMA(1, 0, At, B0); PG8_BAR; PG8_SCHED;
            PG8_STAGE(PG8_SB(1, 1), b3 + hstep, voffB);
            PG8_WAIT_V(6); PG8_BAR; PG8_MMA(1, 1, At, B1); PG8_BAR;
        }
        E(acc, cur, wr, wc, fr, fq);
        if (!has_next) break;
#pragma unroll
        for (int a = 0; a < 2; ++a)
#pragma unroll
            for (int b = 0; b < 2; ++b)
#pragma unroll
                for (int m = 0; m < 4; ++m)
#pragma unroll
                    for (int n = 0; n < 2; ++n) acc[a][b][m][n] = (f32x4){0.f, 0.f, 0.f, 0.f};
        cur = nxt; cA = nA; cB = nB; ++ui;
    }
    PG8_WAIT_V(0);
    if (wr == 0) PG8_BAR;
    PG8_BAR;
#undef PG8_SA
#undef PG8_SB
#undef PG8_STAGE
#undef PG8_LDA
#undef PG8_LDB
#undef PG8_MMA
#undef PG8_WAIT_V
#undef PG8_WAIT_L
#undef PG8_BAR
#undef PG8_SCHED
}

struct Epi {
    static constexpr bool PERM = true;
    int kind; bf16_t* O; const float* xin; float* xout; const float* gate; int pn0, lv;
    __device__ __forceinline__ void operator()(const f32x4 (&acc)[2][2][4][2], const Unit& u, int wr, int wc, int fr, int fq) const {
        const int row0 = u.pm * BM + wr * 64 + fr; const int pn = u.pn; const int cin = wc * 32 + 8 * fq;
        const int pa = pn + pn0, tt = pa - 17 - lv;
        const bool is_glu = kind == 0 && pa >= 17 && !(lv && pa == 17) && tt < 8;
        if (kind == 2) {
            const int col0 = pn * BM + cin;
            const float* gp = gate + (size_t)(u.pm >> 3) * 6144 + col0;
#pragma unroll
            for (int bj = 0; bj < 2; ++bj) {
                const f32x4 g0 = *(const f32x4*)(gp + bj * HALF), g1 = *(const f32x4*)(gp + bj * HALF + 4);
#pragma unroll
                for (int ai = 0; ai < 2; ++ai) {
                    f32x4 x0[4], x1[4];
#pragma unroll
                    for (int m = 0; m < 4; ++m) { const size_t ro = (size_t)(row0 + ai * HALF + m * 16) * D + col0 + bj * HALF; x0[m] = *(const f32x4*)(xin + ro); x1[m] = *(const f32x4*)(xin + ro + 4); }
#pragma unroll
                    for (int m = 0; m < 4; ++m) { const size_t ro = (size_t)(row0 + ai * HALF + m * 16) * D + col0 + bj * HALF;
                        *(f32x4*)(xout + ro) = x0[m] + g0 * acc[ai][bj][m][0]; *(f32x4*)(xout + ro + 4) = x1[m] + g1 * acc[ai][bj][m][1]; } } }
        } else if (is_glu) {
            const int col = OFF_GLU + tt * 128 + cin;
#pragma unroll
            for (int ai = 0; ai < 2; ++ai)
#pragma unroll
                for (int m = 0; m < 4; ++m) { bf16_t* rowp = O + (size_t)(row0 + ai * HALF + m * 16) * LDP + col;
                    f32x4 a0 = acc[ai][0][m][0], a1 = acc[ai][0][m][1], b0 = acc[ai][1][m][0], b1 = acc[ai][1][m][1];
                    u32x4 w; w.x = cvt_pk_bf16(a0[0] * sigm(b0[0]), a0[1] * sigm(b0[1])); w.y = cvt_pk_bf16(a0[2] * sigm(b0[2]), a0[3] * sigm(b0[3]));
                    w.z = cvt_pk_bf16(a1[0] * sigm(b1[0]), a1[1] * sigm(b1[1])); w.w = cvt_pk_bf16(a1[2] * sigm(b1[2]), a1[3] * sigm(b1[3]));
                    *(u32x4*)rowp = w; }
        } else {
            const int mode = kind == 1 ? 2 : ((pa >= 13 && !(lv && pa == 17)) ? 1 : 0);
            const int ldo = kind == 1 ? DFF : LDP;
            const int col = (kind == 1 ? pn * 256 : (pa < 13 ? pa * 256 : (pa < 17 ? OFF_GA + (pa - 13) * 256 : ((lv && pa == 17) ? OFF_VLO : OFF_GB + (tt - 8) * 256)))) + cin;
#pragma unroll
            for (int ai = 0; ai < 2; ++ai)
#pragma unroll
                for (int m = 0; m < 4; ++m) { bf16_t* rowp = O + (size_t)(row0 + ai * HALF + m * 16) * ldo + col;
#pragma unroll
                    for (int bj = 0; bj < 2; ++bj) { f32x4 v0 = acc[ai][bj][m][0], v1 = acc[ai][bj][m][1];
                        if (mode == 1) {
#pragma unroll
                            for (int j = 0; j < 4; ++j) { v0[j] = sigm(v0[j]); v1[j] = sigm(v1[j]); } }
                        else if (mode == 2) {
#pragma unroll
                            for (int j = 0; j < 4; ++j) { const float a = fmaxf(v0[j], 0.f), b = fmaxf(v1[j], 0.f); v0[j] = a * a; v1[j] = b * b; } }
                        u32x4 w; w.x = cvt_pk_bf16(v0[0], v0[1]); w.y = cvt_pk_bf16(v0[2], v0[3]); w.z = cvt_pk_bf16(v1[0], v1[1]); w.w = cvt_pk_bf16(v1[2], v1[3]);
                        *(u32x4*)(rowp + bj * HALF) = w; } }
        }
    }
};
}

struct TileJob { const float* src; int ld, s0, nvalid; bf16_t* dst; int K, d0, k0; };
__device__ __forceinline__ void tile_load(const TileJob& t, f32x4 (&v)[2]) {
    const int tid = otid(); const int kk = tid >> 4, c4 = (tid & 15) * 4;
#pragma unroll
    for (int p = 0; p < 2; ++p) { v[p] = (f32x4){0.f, 0.f, 0.f, 0.f};
        if (t.src != nullptr && c4 < t.nvalid) v[p] = __builtin_nontemporal_load((const f32x4*)(t.src + (size_t)(t.k0 + kk + 32 * p) * t.ld + t.s0 + c4)); }
}
__device__ __forceinline__ void tile_store(const TileJob& t, const f32x4 (&v)[2], LAS float* tile) {
    const int tid = otid();
    { const int kk = tid >> 4, c4 = (tid & 15) * 4;
#pragma unroll
      for (int p = 0; p < 2; ++p) { const int k = kk + 32 * p;
          tile[k * 65 + c4 + 0] = v[p][0]; tile[k * 65 + c4 + 1] = v[p][1]; tile[k * 65 + c4 + 2] = v[p][2]; tile[k * 65 + c4 + 3] = v[p][3]; } }
    __syncthreads();
    { const int nn = tid >> 3, k8 = (tid & 7) * 8; float x[8];
#pragma unroll
      for (int j = 0; j < 8; ++j) x[j] = tile[(k8 + j) * 65 + nn];
      u32x4 w; w.x = cvt_pk_bf16(x[0], x[1]); w.y = cvt_pk_bf16(x[2], x[3]); w.z = cvt_pk_bf16(x[4], x[5]); w.w = cvt_pk_bf16(x[6], x[7]);
      *(u32x4*)(t.dst + (size_t)(t.d0 + nn) * t.K + t.k0 + k8) = w; }
    __syncthreads();
}

namespace pj {
constexpr int J_IN0 = (NP0 / 64) * 16, J_IN1 = (NP1 / 64) * 16, J_OUT = 16 * 32, J_F1 = 64 * 16, J_F2 = 16 * 64;
constexpr int E0 = J_IN0, E1 = E0 + J_IN1, E2 = E1 + 2 * J_OUT, E3 = E2 + 2 * J_F1, E4 = E3 + 2 * J_F2, TOT = E4 + 192;
}
__device__ __forceinline__ void tile_decode(KParamsPtr p, int j, TileJob& t) {
    using namespace pj;
    if (j < E1) {
        const int l = j < E0 ? 0 : 1; const int r = j - (l ? E0 : 0); const int nt = r >> 4, kt = r & 15; const int d0 = nt * 64;
        const float* src = p->w_in + (size_t)l * 1024 * NCOLS; int ld = NCOLS, s0 = d0, nvalid = 64;
        { const int tI = d0 >> 8, e = d0 & 255;
          if (tI < 13) s0 = d0;
          else if (tI < 17) s0 = 5376 + (tI - 13) * 256 + e;
          else if (l == 1 && tI == 17) { if (e == 0) { src = p->w_in_vres; ld = 32; s0 = 0; nvalid = 32; } else src = nullptr; }
          else { const int tt = tI - 17 - l; if (tt < 8) s0 = e < 128 ? 3328 + tt * 128 + e : 4352 + tt * 128 + (e - 128); else s0 = 6400 + (tt - 8) * 256 + e; } }
        t.src = src; t.ld = ld; t.s0 = s0; t.nvalid = nvalid; t.dst = (bf16_t*)(g_buf + G_WIN) + (size_t)l * 7680 * 1024; t.K = 1024; t.d0 = d0; t.k0 = kt * 64;
    } else if (j < E2) { const int r0 = j - E1; const int l = r0 / J_OUT, r = r0 % J_OUT; const int nt = r >> 5, kt = r & 31;
        t.src = p->w_out + (size_t)l * 2048 * 1024; t.ld = 1024; t.s0 = nt * 64; t.nvalid = 64; t.dst = (bf16_t*)(g_buf + G_WOUT) + (size_t)l * 1024 * 2048; t.K = 2048; t.d0 = nt * 64; t.k0 = kt * 64;
    } else if (j < E3) { const int r0 = j - E2; const int l = r0 / J_F1, r = r0 % J_F1; const int nt = r >> 4, kt = r & 15;
        t.src = p->w_ff_in + (size_t)l * 1024 * 4096; t.ld = 4096; t.s0 = nt * 64; t.nvalid = 64; t.dst = (bf16_t*)(g_buf + G_WF1) + (size_t)l * 4096 * 1024; t.K = 1024; t.d0 = nt * 64; t.k0 = kt * 64;
    } else { const int r0 = j - E3; const int l = r0 / J_F2, r = r0 % J_F2; const int nt = r >> 6, kt = r & 63;
        t.src = p->w_ff_out + (size_t)l * 4096 * 1024; t.ld = 1024; t.s0 = nt * 64; t.nvalid = 64; t.dst = (bf16_t*)(g_buf + G_WF2) + (size_t)l * 1024 * 4096; t.K = 4096; t.d0 = nt * 64; t.k0 = kt * 64;
    }
}
__device__ void prep_job(KParamsPtr p, int j, LAS float* lds) {
    using namespace pj;
    const int tid = otid();
    {
        if (j < E4) { TileJob t; tile_decode(p, j, t); f32x4 v[2]; tile_load(t, v); tile_store(t, v, lds);
        } else {
            const int mj = j - E4; const int l = mj / 96, n0 = (mj % 96) * 64;
            LAS float* cact = lds; LAS float* red = lds + 8192;
            for (int i = tid; i < 8192; i += 512) { const float v = p->c[i]; cact[i] = v * sigm(v); }
            __syncthreads();
            const int kq = tid >> 6, nn = tid & 63; float a[8];
#pragma unroll
            for (int b = 0; b < 8; ++b) a[b] = 0.f;
            const float* wp = p->ada_w + (size_t)l * 1024 * 6144 + n0 + nn;
#pragma unroll 16
            for (int k = kq * 128; k < kq * 128 + 128; ++k) { const float w = wp[(size_t)k * 6144];
#pragma unroll
                for (int b = 0; b < 8; ++b) a[b] += cact[b * 1024 + k] * w; }
#pragma unroll
            for (int b = 0; b < 8; ++b) red[(kq * 8 + b) * 64 + nn] = a[b];
            __syncthreads();
            { const int b = tid >> 6; float s = p->ada_b[l * 6144 + n0 + nn];
#pragma unroll
              for (int q = 0; q < 8; ++q) s += red[(q * 8 + b) * 64 + nn];
              ((float*)(p->ws + WS_MOD))[(size_t)(l * 8 + b) * 6144 + n0 + nn] = s; }
            __syncthreads();
        }
    }
}
constexpr int PREP_AT = pj::E0 + pj::J_F2;
__device__ void prep_phase(KParamsPtr p, LAS float* lds) {
    if (blockIdx.x == 0 && otid() < 8) ((int*)(p->ws + WS_CTR))[otid()] = 0;
    int a0 = blockIdx.x, aend = PREP_AT, astr = gridDim.x;
    if (gridDim.x == 256) { constexpr int NA = 2560; if (blockIdx.x >= 96) { a0 = blockIdx.x - 96; aend = NA; astr = 160; } else { a0 = NA + blockIdx.x; astr = 96; } }
    if (gridDim.x != 256 || blockIdx.x < 96) for (int m = blockIdx.x; m < 96; m += gridDim.x) prep_job(p, pj::E4 + m, lds);
    { int a = a0; TileJob tc, tn; f32x4 vc[2], vn[2];
      if (a < aend) { tile_decode(p, a < pj::E0 ? a : pj::E3 + (a - pj::E0), tc); tile_load(tc, vc); }
      for (; a < aend; a += astr) { const int an = a + astr; const bool more = an < aend;
          if (more) { tile_decode(p, an < pj::E0 ? an : pj::E3 + (an - pj::E0), tn); tile_load(tn, vn); }
          tile_store(tc, vc, lds);
          if (more) { tc = tn; vc[0] = vn[0]; vc[1] = vn[1]; } } }
}
constexpr int PREP_B0 = pj::J_IN1 + pj::J_OUT + pj::J_F1 + 96, PREP_B1 = pj::J_OUT + pj::J_F1 + pj::J_F2;
__device__ __forceinline__ int prep_b_job(int l, int q) {
    using namespace pj;
    if (l == 0) {
        if (q < J_IN1) return E0 + q; q -= J_IN1;
        if (q < J_OUT) return E1 + q; q -= J_OUT;
        if (q < J_F1) return E2 + q; q -= J_F1;
        return E4 + 96 + q;
    }
    if (q < J_OUT) return E1 + J_OUT + q; q -= J_OUT;
    if (q < J_F1) return E2 + J_F1 + q; q -= J_F1;
    return E3 + J_F2 + q;
}

__device__ __forceinline__ void norm_row_finish(const f32x4 (&v)[4], const f32x4 (&g)[4], const f32x4 (&sc)[4], const f32x4 (&sh)[4], bf16_t* hrow, int lane) {
    float ss = 0.f;
#pragma unroll
    for (int i = 0; i < 4; ++i) ss += v[i][0] * v[i][0] + v[i][1] * v[i][1] + v[i][2] * v[i][2] + v[i][3] * v[i][3];
    ss = red64(ss);
    const float rs = rsqrtf(ss * (1.0f / 1024.0f) + 1e-6f);
#pragma unroll
    for (int i = 0; i < 4; ++i) { const int c = i * 256 + lane * 4; f32x4 y;
#pragma unroll
        for (int j = 0; j < 4; ++j) y[j] = (v[i][j] * rs) * g[i][j] * (1.0f + sc[i][j]) + sh[i][j];
        u32x2 w; w.x = cvt_pk_bf16(y[0], y[1]); w.y = cvt_pk_bf16(y[2], y[3]);
        *(u32x2*)(hrow + c) = w; }
}
__device__ void norm_phase(const float* xin, bf16_t* hout, const float* gain, const float* modl, int sh_off, int sc_off) {
    const int tid_ = otid(); const int wave = tid_ >> 6, lane = tid_ & 63;
    const int S = gridDim.x * 8;
    f32x4 g[4];
#pragma unroll
    for (int i = 0; i < 4; ++i) g[i] = *(const f32x4*)(gain + i * 256 + lane * 4);
    for (int row = blockIdx.x * 8 + wave; row < M; row += 2 * S) {
        const int rowb = row + S; const bool hb = rowb < M; const int rb = hb ? rowb : row;
        const float* xa = xin + (size_t)row * D; const float* xb = xin + (size_t)rb * D;
        const float* ma = modl + (size_t)(row >> 11) * 6144; const float* mb = modl + (size_t)(rb >> 11) * 6144;
        f32x4 va[4], vb[4], sca[4], sha[4], scb[4], shb[4];
#pragma unroll
        for (int i = 0; i < 4; ++i) { const int c = i * 256 + lane * 4; va[i] = *(const f32x4*)(xa + c); vb[i] = *(const f32x4*)(xb + c);
            sca[i] = *(const f32x4*)(ma + sc_off + c); sha[i] = *(const f32x4*)(ma + sh_off + c); scb[i] = *(const f32x4*)(mb + sc_off + c); shb[i] = *(const f32x4*)(mb + sh_off + c); }
        norm_row_finish(va, g, sca, sha, hout + (size_t)row * D, lane);
        if (hb) norm_row_finish(vb, g, scb, shb, hout + (size_t)rowb * D, lane);
    }
}
__device__ void final_norm_phase(float* x, const float* gain) {
    const int tid_ = otid(); const int wave = tid_ >> 6, lane = tid_ & 63;
    const int S = gridDim.x * 8;
    f32x4 g[4];
#pragma unroll
    for (int i = 0; i < 4; ++i) g[i] = *(const f32x4*)(gain + i * 256 + lane * 4);
    for (int row = blockIdx.x * 8 + wave; row < M; row += 2 * S) {
        const int rowb = row + S; const bool hb = rowb < M; const int rb = hb ? rowb : row;
        float* xa = x + (size_t)row * D; float* xb = x + (size_t)rb * D;
        f32x4 va[4], vb[4];
#pragma unroll
        for (int i = 0; i < 4; ++i) { va[i] = *(const f32x4*)(xa + i * 256 + lane * 4); vb[i] = *(const f32x4*)(xb + i * 256 + lane * 4); }
#pragma unroll
        for (int h = 0; h < 2; ++h) { if (h == 1 && !hb) break;
            float ss = 0.f;
#pragma unroll
            for (int i = 0; i < 4; ++i) { const f32x4 t = h ? vb[i] : va[i]; ss += t[0] * t[0] + t[1] * t[1] + t[2] * t[2] + t[3] * t[3]; }
            ss = red64(ss);
            const float rs = rsqrtf(ss * (1.0f / 1024.0f) + 1e-6f);
            float* xr = h ? xb : xa;
#pragma unroll
            for (int i = 0; i < 4; ++i) { const f32x4 t = h ? vb[i] : va[i]; f32x4 y;
#pragma unroll
                for (int j = 0; j < 4; ++j) y[j] = (t[j] * rs) * g[i][j];
                *(f32x4*)(xr + i * 256 + lane * 4) = y; } }
    }
}

__device__ void lo_prep_phase(KParamsPtr p, int l) {
    const int tid = otid();
    const bf16_t* proj = (const bf16_t*)(p->ws + WS_PROJ); bf16_t* loa = (bf16_t*)(p->ws + WS_LOA);
    const int stride = gridDim.x * 512;
    constexpr int NBAT = 5;
    for (int base = blockIdx.x * 512 + tid; base < M * 36; base += NBAT * stride) {
        u32x4 rc4[NBAT], rp4[NBAT]; f32x4 m0[NBAT], m1[NBAT];
#pragma unroll
        for (int i = 0; i < NBAT; ++i) { const int idx = base + i * stride; rc4[i] = (u32x4){0u, 0u, 0u, 0u}; rp4[i] = rc4[i]; m0[i] = (f32x4){0.f, 0.f, 0.f, 0.f}; m1[i] = m0[i];
            if (idx < M * 36) { const int row = idx / 36, q8 = (idx - row * 36) * 8;
                if (q8 < 256 || l > 0) {
                    const int col = q8 < 256 ? 3072 + q8 : OFF_VLO + (q8 - 256);
                    const float* mup = q8 < 256 ? p->mu_shift + l * 3328 + 3072 + q8 : p->mu_vres + (q8 - 256);
                    m0[i] = *(const f32x4*)mup; m1[i] = *(const f32x4*)(mup + 4);
                    const bf16_t* src = proj + (size_t)row * LDP + col;
                    rc4[i] = *(const u32x4*)src;
                    if ((row & (T - 1)) != 0) rp4[i] = *(const u32x4*)(src - LDP); } } }
#pragma unroll
        for (int i = 0; i < NBAT; ++i) { const int idx = base + i * stride;
            if (idx < M * 36) { const int row = idx / 36, q8 = (idx - row * 36) * 8;
                u32x4 w = (u32x4){0u, 0u, 0u, 0u};
                if (q8 < 256 || l > 0) {
                    f32x4 c0 = (f32x4){bflo(rc4[i].x), bfhi(rc4[i].x), bflo(rc4[i].y), bfhi(rc4[i].y)}, c1 = (f32x4){bflo(rc4[i].z), bfhi(rc4[i].z), bflo(rc4[i].w), bfhi(rc4[i].w)};
                    const f32x4 p0 = (f32x4){bflo(rp4[i].x), bfhi(rp4[i].x), bflo(rp4[i].y), bfhi(rp4[i].y)}, p1 = (f32x4){bflo(rp4[i].z), bfhi(rp4[i].z), bflo(rp4[i].w), bfhi(rp4[i].w)};
                    c0 = c0 + (p0 - c0) * m0[i]; c1 = c1 + (p1 - c1) * m1[i];
                    if (q8 < 64) {
#pragma unroll
                        for (int j = 0; j < 4; ++j) { c0[j] = 1.0f - 2.0f * __builtin_amdgcn_rcpf(__expf(2.0f * c0[j]) + 1.0f); c1[j] = 1.0f - 2.0f * __builtin_amdgcn_rcpf(__expf(2.0f * c1[j]) + 1.0f); } }
                    else if (q8 >= 128 && q8 < 256) {
#pragma unroll
                        for (int j = 0; j < 4; ++j) { c0[j] = sigm(c0[j]); c1[j] = sigm(c1[j]); } }
                    w.x = cvt_pk_bf16(c0[0], c0[1]); w.y = cvt_pk_bf16(c0[2], c0[3]); w.z = cvt_pk_bf16(c1[0], c1[1]); w.w = cvt_pk_bf16(c1[2], c1[3]);
                }
                *(u32x4*)(loa + (size_t)row * 288 + q8) = w; } }
    }
}

__device__ __forceinline__ void lds_barrier() { asm volatile("s_waitcnt lgkmcnt(0)\n\ts_barrier" ::: "memory"); }

constexpr int TC = 32;
constexpr int LOSB = 296;
constexpr int LB_LO = 0, LB_PRE = LB_LO + TC * LOSB * 2, LB_OPS = LB_PRE + 4 * TC * 64 * 4, LB_Y = LB_OPS + 6 * TC * 64 * 4, LB_CONST = LB_Y + TC * 64 * 4, LB_MU = LB_CONST + 8 * 64 * 4, LB_BON = LB_MU + 480 * 4;
constexpr int CS = 72, CS2 = 40;
constexpr int IMG_AT = 0, IMG_RT = IMG_AT + 16 * CS * 2, IMG_BT = IMG_RT + 16 * CS * 2, IMG_KT = IMG_BT + 16 * CS * 2, IMG_BKT = IMG_KT + 16 * CS * 2,
              IMG_UVT = IMG_BKT + 64 * CS2 * 2, IMG_A2 = IMG_UVT + 64 * CS2 * 2, IMG_A3 = IMG_A2 + 16 * CS2 * 2, IMG_LF = IMG_A3 + 16 * CS2 * 2, IMG_PV = IMG_LF + 16 * 16 * 4, IMG_SIZE = IMG_PV + 64 * 4;
static_assert(2 * IMG_SIZE <= 6 * TC * 64 * 4, "two image sets must fit the operand-array region");
constexpr int LB_CLW = 0;
constexpr int LB_S0B = LB_BON, LB_BFR = LB_S0B + 64 * CS * 2, LB_RHS = LB_BFR + 9 * 4 * 64 * 16, LB_END = LB_RHS + 16 * 64 * 4;
static_assert(LB_END <= LDS_BYTES - 16, "scan LDS (the last 16 bytes hold the grid barrier's set-up words)");

__device__ __forceinline__ f32x4 unpk4(u32x2 w) { return (f32x4){bflo(w.x), bfhi(w.x), bflo(w.y), bfhi(w.y)}; }
__device__ __forceinline__ float tanh_fast(float x) { return 1.0f - 2.0f / (__expf(2.0f * x) + 1.0f); }

__device__ void scan_item(KParamsPtr p, int l, int b, int h, LAS unsigned char* ldsb) {
    const int tid = otid(), wave = tid >> 6, lane = tid & 63;
    const bf16_t* proj = (const bf16_t*)(p->ws + WS_PROJ);
    bf16_t* merged = (bf16_t*)(g_buf + G_MERGED);
    bf16_t* vfirst = (bf16_t*)(g_buf + G_VFIRST);
    const int C0 = h * 64;
    const size_t rowbase = (size_t)b * T;
    LAS float* PRE = (LAS float*)(ldsb + LB_PRE); LAS float* OPS = (LAS float*)(ldsb + LB_OPS); LAS float* Yb = (LAS float*)(ldsb + LB_Y);
    LAS float* CST = (LAS float*)(ldsb + LB_CONST); LAS float* MU = (LAS float*)(ldsb + LB_MU);
    {
        const int kind = tid >> 6, c = tid & 63; float v = 0.f;
        if (kind == 0) v = p->w0[l * 1024 + C0 + c]; else if (kind == 1) v = p->a0[l * 1024 + C0 + c]; else if (kind == 2) v = p->k_k[l * 1024 + C0 + c];
        else if (kind == 3) v = p->k_a[l * 1024 + C0 + c]; else if (kind == 4) v = p->r_k[l * 1024 + C0 + c]; else if (kind == 5) v = p->gn_gain[l * 1024 + C0 + c];
        else if (kind == 6) v = p->gn_bias[l * 1024 + C0 + c]; else v = (l > 0) ? p->v0[C0 + c] : 0.f;
        CST[tid] = v;
        if (tid < 480) { float m;
            if (tid < 256) m = p->mu_shift[l * 3328 + 3072 + tid]; else if (tid < 288) m = (l > 0) ? p->mu_vres[tid - 256] : 0.f;
            else { const int a = (tid - 288) >> 6, c2 = (tid - 288) & 63; m = p->mu_shift[l * 3328 + a * 1024 + C0 + c2]; }
            MU[tid] = m; }
    }
    const int rt = wave >> 2, ct = wave & 3;
    const int ig = (tid >> 4) & 15, jg = tid & 15;
    const int pt = tid >> 4, pc = (tid & 15) * 4;
    const int C = C0 + pc;
    f32x4 accS[4];
#pragma unroll
    for (int x = 0; x < 4; ++x) accS[x] = (f32x4){0.f, 0.f, 0.f, 0.f};
    for (int i = tid; i < 64 * CS * 2 / 4; i += 512) *(LAS unsigned*)(ldsb + LB_S0B + i * 4) = 0u;
    const int r16 = lane & 15, g4 = lane >> 4;
    u32x4 rawc[3]; u32x2 rc, rp, kc, kp, vc, vp, gAw, vfw;
    const bf16_t* loa = (const bf16_t*)(p->ws + WS_LOA);
#define SCAN_PF_LO(t0_) do { \
        _Pragma("unroll") for (int i = 0; i < 3; ++i) { const int idx = tid + 512 * i; rawc[i] = (u32x4){0u, 0u, 0u, 0u}; \
            if (idx < TC * 36) rawc[i] = *(const u32x4*)(loa + (rowbase + (t0_)) * 288 + idx * 8); } } while (0)
#define SCAN_PF_RKV(t0_) do { \
        { const bf16_t* src = proj + (rowbase + (t0_) + pt) * LDP + C; const bool nf = ((t0_) + pt) > 0; const u32x2 z2 = (u32x2){0u, 0u}; \
          rc = *(const u32x2*)src; kc = *(const u32x2*)(src + 1024); vc = *(const u32x2*)(src + 2048); gAw = *(const u32x2*)(src + OFF_GA); \
          rp = nf ? *(const u32x2*)(src - LDP) : z2; kp = nf ? *(const u32x2*)(src - LDP + 1024) : z2; vp = nf ? *(const u32x2*)(src - LDP + 2048) : z2; \
          vfw = z2; if (l > 0) vfw = *(const u32x2*)(vfirst + (rowbase + (t0_) + pt) * 1024 + C); } } while (0)
#define SCAN_LO_COPY() do { _Pragma("unroll") for (int i = 0; i < 3; ++i) { const int idx = tid + 512 * i; \
            if (idx < TC * 36) { const int t = idx / 36, q8 = (idx - t * 36) * 8; *(LAS u32x4*)(ldsb + LB_LO + (t * LOSB + q8) * 2) = rawc[i]; } } } while (0)
#define SCAN_UPPROJ_T(rt, ct) do { f32x4 acc[4]; _Pragma("unroll") for (int k = 0; k < 4; ++k) acc[k] = (f32x4){0.f, 0.f, 0.f, 0.f}; \
            const LAS unsigned char* ap = ldsb + LB_LO + ((rt * 16 + (lane & 15)) * LOSB + (lane >> 4) * 8) * 2; \
            _Pragma("unroll") for (int ks = 0; ks < 9; ++ks) { const int kind = ks < 2 ? 0 : (ks < 4 ? 1 : (ks < 8 ? 2 : 3)); \
                const bf16x8 a = *(const LAS bf16x8*)(ap + ks * 64); const bf16x8 bq = *(const LAS bf16x8*)(ldsb + LB_BFR + ((ks * 4 + ct) * 64 + lane) * 16); \
                acc[kind] = __builtin_amdgcn_mfma_f32_16x16x32_bf16(a, bq, acc[kind], 0, 0, 0); } \
            _Pragma("unroll") for (int k = 0; k < 4; ++k) _Pragma("unroll") for (int r = 0; r < 4; ++r) PRE[(k * TC + rt * 16 + (lane >> 4) * 4 + r) * 64 + ct * 16 + (lane & 15)] = acc[k][r]; } while (0)
#define SCAN_POST(t0_, gg_, bonv_) do { const size_t row = rowbase + (t0_) + pt; \
            const f32x4 y = *(const LAS f32x4*)(Yb + pt * 64 + pc); \
            const f32x4 gng = *(const LAS f32x4*)(CST + 5 * 64 + pc), gnb = *(const LAS f32x4*)(CST + 6 * 64 + pc); \
            const float mean = red16(y[0] + y[1] + y[2] + y[3]) * (1.0f / 64.0f); \
            const f32x4 dv = y - mean; \
            const float var = red16(dv[0] * dv[0] + dv[1] * dv[1] + dv[2] * dv[2] + dv[3] * dv[3]) * (1.0f / 64.0f); \
            const float rstd = rsqrtf(var + 64e-5f); \
            f32x4 o; _Pragma("unroll") for (int j = 0; j < 4; ++j) o[j] = (dv[j] * rstd * gng[j] + gnb[j] + (bonv_)[j]) * (gg_)[j]; \
            u32x2 w; w.x = cvt_pk_bf16(o[0], o[1]); w.y = cvt_pk_bf16(o[2], o[3]); \
            *(u32x2*)(merged + row * 2048 + C) = w; } while (0)
#define SCAN_LW_ROW(row_, pc_) do { const f32x4 aw = *(const LAS f32x4*)(PRE + (0 * TC + (row_)) * 64 + (pc_)) + *(const LAS f32x4*)(CST + 0 * 64 + (pc_)); f32x4 lw; \
            _Pragma("unroll") for (int j = 0; j < 4; ++j) lw[j] = -0.60653065971f * sigm(aw[j]); \
            *(LAS f32x4*)(ldsb + LB_CLW + ((row_) * 64 + (pc_)) * 4) = lw; } while (0)
#define SCAN_CUMSUM(sb_, ct_) do { const int sb = (sb_), ct = (ct_); f32x4 acc = (f32x4){0.f, 0.f, 0.f, 0.f}; float bv[4]; \
            _Pragma("unroll") for (int ks = 0; ks < 4; ++ks) bv[ks] = *(const LAS float*)(ldsb + LB_CLW + ((sb * 16 + g4 + 4 * ks) * 64 + ct * 16 + r16) * 4); \
            _Pragma("unroll") for (int ks = 0; ks < 4; ++ks) acc = __builtin_amdgcn_mfma_f32_16x16x4f32((g4 + 4 * ks <= r16) ? 1.0f : 0.0f, bv[ks], acc, 0, 0, 0); \
            _Pragma("unroll") for (int e = 0; e < 4; ++e) *(LAS float*)(ldsb + LB_CLW + ((sb * 16 + g4 * 4 + e) * 64 + ct * 16 + r16) * 4) = acc[e]; } while (0)
    SCAN_PF_LO(0); SCAN_PF_RKV(0);
    {
        const int ch = C0 + ct * 16 + (lane & 15), q0 = (lane >> 4) * 8;
#pragma unroll
        for (int ki = 0; ki < 5; ++ki) { const int ks = rt + 2 * ki; if (ks < 9) {
            const float* src; int q;
            if (ks < 2) { src = p->w_decay_up + (size_t)l * 64 * 1024; q = ks * 32 + q0; }
            else if (ks < 4) { src = p->w_aaa_up + (size_t)l * 64 * 1024; q = (ks - 2) * 32 + q0; }
            else if (ks < 8) { src = p->w_gate_up + (size_t)l * 128 * 1024; q = (ks - 4) * 32 + q0; }
            else { src = p->w_vres_up; q = q0; }
            float f[8];
#pragma unroll
            for (int j = 0; j < 8; ++j) f[j] = (ks == 8 && l == 0) ? 0.f : src[(size_t)(q + j) * 1024 + ch];
            u32x4 w; w.x = cvt_pk_bf16(f[0], f[1]); w.y = cvt_pk_bf16(f[2], f[3]); w.z = cvt_pk_bf16(f[4], f[5]); w.w = cvt_pk_bf16(f[6], f[7]);
            *(LAS u32x4*)(ldsb + LB_BFR + ((ks * 4 + ct) * 64 + lane) * 16) = w;
        } }
    }
    lds_barrier();
    SCAN_LO_COPY();
    SCAN_PF_LO(TC);
    lds_barrier();
    SCAN_UPPROJ_T(rt, ct);
    lds_barrier();
    SCAN_LW_ROW(pt, pc);
    lds_barrier();
    SCAN_CUMSUM(wave >> 2, wave & 3);
    lds_barrier();
    f32x4 gg = (f32x4){0.f, 0.f, 0.f, 0.f}, bonv = gg;

    for (int chn = 0; chn < T / TC; ++chn) {
        const int t0 = chn * TC;
        if (chn > 0) SCAN_POST(t0 - TC, gg, bonv);
        {
            const size_t row = rowbase + t0 + pt; const int sb = pt >> 4, st = pt & 15;
            LAS unsigned char* img = ldsb + LB_OPS + sb * IMG_SIZE;
            const f32x4 aa = *(const LAS f32x4*)(PRE + (1 * TC + pt) * 64 + pc) + *(const LAS f32x4*)(CST + 1 * 64 + pc);
            const f32x4 ag = *(const LAS f32x4*)(PRE + (2 * TC + pt) * 64 + pc);
            const f32x4 av = *(const LAS f32x4*)(PRE + (3 * TC + pt) * 64 + pc) + *(const LAS f32x4*)(CST + 7 * 64 + pc);
            const f32x4 kkv = *(const LAS f32x4*)(CST + 2 * 64 + pc), kav = *(const LAS f32x4*)(CST + 3 * 64 + pc), rkv = *(const LAS f32x4*)(CST + 4 * 64 + pc);
            const f32x4 mr = *(const LAS f32x4*)(MU + 288 + pc), mk = *(const LAS f32x4*)(MU + 352 + pc), mv = *(const LAS f32x4*)(MU + 416 + pc);
            const f32x4 Lt = *(const LAS f32x4*)(ldsb + LB_CLW + (pt * 64 + pc) * 4);
            f32x4 Lm = (f32x4){0.f, 0.f, 0.f, 0.f};
            if (st > 0) Lm = *(const LAS f32x4*)(ldsb + LB_CLW + ((pt - 1) * 64 + pc) * 4);
#define PR2(w_) ((f32x2){bflo(w_), bfhi(w_)})
#define HF2(v_, h_) ((f32x2){(v_)[2 * (h_)], (v_)[2 * (h_) + 1]})
            f32x2 r2[2], k2v[2], v2[2], a2[2], kk2[2], k22[2]; f32x2 ss2 = (f32x2){0.f, 0.f}, bon2 = (f32x2){0.f, 0.f};
#pragma unroll
            for (int h = 0; h < 2; ++h) {
                const f32x2 rcu = PR2(h ? rc.y : rc.x), rpu = PR2(h ? rp.y : rp.x), kcu = PR2(h ? kc.y : kc.x), kpu = PR2(h ? kp.y : kp.x), vcu = PR2(h ? vc.y : vc.x), vpu = PR2(h ? vp.y : vp.x);
                r2[h] = rcu + (rpu - rcu) * HF2(mr, h); k2v[h] = kcu + (kpu - kcu) * HF2(mk, h); v2[h] = vcu + (vpu - vcu) * HF2(mv, h);
                if (l > 0) { const f32x2 vf = PR2(h ? vfw.y : vfw.x); const f32x2 sg = (f32x2){sigm(av[2 * h]), sigm(av[2 * h + 1])}; v2[h] = v2[h] + (vf - v2[h]) * sg; }
                a2[h] = (f32x2){sigm(aa[2 * h]), sigm(aa[2 * h + 1])};
                kk2[h] = k2v[h] * HF2(kkv, h); ss2 += kk2[h] * kk2[h];
                k22[h] = k2v[h] * ((a2[h] - 1.0f) * HF2(kav, h) + 1.0f);
                bon2 += r2[h] * k22[h] * HF2(rkv, h);
            }
            if (l == 0) { u32x2 w; w.x = cvt_pk_bf16(v2[0].x, v2[0].y); w.y = cvt_pk_bf16(v2[1].x, v2[1].y); *(u32x2*)(vfirst + row * 1024 + C) = w; }
            const float ss = red16(ss2.x + ss2.y), bon = red16(bon2.x + bon2.y);
            const float inv = __builtin_amdgcn_rsqf(fmaxf(ss, 1e-24f));
            u32x2 wa, wr2, wb, wk, wv;
#pragma unroll
            for (int h = 0; h < 2; ++h) {
                const f32x2 kn = kk2[h] * inv;
                const f32x2 ep = (f32x2){__expf(Lt[2 * h]), __expf(Lt[2 * h + 1])}, en = (f32x2){__expf(-Lt[2 * h]), __expf(-Lt[2 * h + 1])}, em = (f32x2){__expf(Lm[2 * h]), __expf(Lm[2 * h + 1])};
                const f32x2 at = -(kn * em), rt2 = r2[h] * ep, bt = kn * a2[h] * en, kt = k22[h] * en;
                if (st == 15) *(LAS f32x2*)(img + IMG_PV + (pc + 2 * h) * 4) = ep;
                const unsigned ua = cvt_pk_bf16(at.x, at.y), ur = cvt_pk_bf16(rt2.x, rt2.y), ub = cvt_pk_bf16(bt.x, bt.y), uk = cvt_pk_bf16(kt.x, kt.y), uv = cvt_pk_bf16(v2[h].x, v2[h].y);
                if (h == 0) { wa.x = ua; wr2.x = ur; wb.x = ub; wk.x = uk; wv.x = uv; } else { wa.y = ua; wr2.y = ur; wb.y = ub; wk.y = uk; wv.y = uv; }
            }
            const f32x4 v4 = (f32x4){v2[0].x, v2[0].y, v2[1].x, v2[1].y};
            const f32x4 gA = unpk4(gAw);
#undef PR2
#undef HF2
            *(LAS u32x2*)(img + IMG_AT + (st * CS + pc) * 2) = wa; *(LAS u32x2*)(img + IMG_RT + (st * CS + pc) * 2) = wr2;
            *(LAS u32x2*)(img + IMG_BT + (st * CS + pc) * 2) = wb; *(LAS u32x2*)(img + IMG_KT + (st * CS + pc) * 2) = wk;
#pragma unroll
            for (int j = 0; j < 4; ++j) { const unsigned xb = j < 2 ? wb.x : wb.y, xk = j < 2 ? wk.x : wk.y, xv = j < 2 ? wv.x : wv.y; const int sh = (j & 1) * 16;
                *(LAS bf16_t*)(img + IMG_BKT + ((pc + j) * CS2 + st) * 2) = (bf16_t)(xb >> sh);
                *(LAS bf16_t*)(img + IMG_BKT + ((pc + j) * CS2 + 16 + st) * 2) = (bf16_t)(xk >> sh);
                *(LAS bf16_t*)(img + IMG_UVT + ((pc + j) * CS2 + 16 + st) * 2) = (bf16_t)(xv >> sh); }
            gg = ag * gA; bonv = bon * v4;
            if (tid < 320) { const int sb2 = tid >= 160, q = tid - sb2 * 160; const int rr2 = q >> 1, hf = (q & 1) * 16; const u32x4 z4 = (u32x4){0u, 0u, 0u, 0u};
                LAS unsigned char* im2 = ldsb + LB_OPS + sb2 * IMG_SIZE;
                if (rr2 < 64) *(LAS u32x4*)(im2 + IMG_UVT + rr2 * CS2 * 2 + hf) = z4; else *(LAS u32x4*)(im2 + IMG_A3 + (rr2 - 64) * CS2 * 2 + hf) = z4; }
        }
        if (chn + 1 < T / TC) SCAN_PF_RKV(t0 + TC);
        lds_barrier();
        {
            const int sb = wave >> 2, pr = wave & 3; LAS unsigned char* img = ldsb + LB_OPS + sb * IMG_SIZE;
            const int fo = (r16 * CS + g4 * 8) * 2;
            const LAS unsigned char* As = img + ((pr & 2) ? IMG_RT : IMG_AT); const LAS unsigned char* Bs = img + ((pr & 1) ? IMG_KT : IMG_BT);
            f32x4 d = (f32x4){0.f, 0.f, 0.f, 0.f};
#pragma unroll
            for (int ks = 0; ks < 2; ++ks) d = __builtin_amdgcn_mfma_f32_16x16x32_bf16(*(const LAS bf16x8*)(As + fo + ks * 64), *(const LAS bf16x8*)(Bs + fo + ks * 64), d, 0, 0, 0);
#pragma unroll
            for (int e = 0; e < 4; ++e) { const int t = g4 * 4 + e, tau = r16;
                if (pr == 0) *(LAS float*)(img + IMG_LF + (t * 16 + tau) * 4) = tau < t ? d[e] : 0.f;
                else { const float val = (pr == 1 ? tau < t : tau <= t) ? d[e] : 0.f; const unsigned wv = cvt_pk_bf16(val, val);
                    const int base = pr == 1 ? IMG_A3 + 32 : (pr == 2 ? IMG_A2 : IMG_A2 + 32);
                    *(LAS bf16_t*)(img + base + (t * CS2 + tau) * 2) = (bf16_t)(wv & 0xffffu); } }
        }
        if (chn + 1 < T / TC) { SCAN_LO_COPY(); if (chn + 2 < T / TC) SCAN_PF_LO(t0 + 2 * TC); }
        lds_barrier();
        if (wave < 2) {
            LAS unsigned char* img = ldsb + LB_OPS + wave * IMG_SIZE;
            float u[16]; int lq[4];
#pragma unroll
            for (int q = 0; q < 4; ++q) lq[q] = *(const LAS int*)(img + IMG_LF + (q * 64 + lane) * 4);
#pragma unroll
            for (int t = 0; t < 16; ++t) u[t] = (t == r16) ? 1.0f : 0.0f;
#pragma unroll
            for (int tau = 0; tau < 15; ++tau)
#pragma unroll
                for (int t = tau + 1; t < 16; ++t) { const int idx = t * 16 + tau; const float lf = __builtin_bit_cast(float, __builtin_amdgcn_readlane(lq[idx >> 6], idx & 63)); u[t] += lf * u[tau]; }
            if (g4 == 0) {
#pragma unroll
                for (int t = 0; t < 16; ++t) *(LAS float*)(img + IMG_LF + (t * 16 + r16) * 4) = u[t]; }
        }
        if (chn + 1 < T / TC) {
            const int ntile = wave < 2 ? 0 : (wave < 4 ? 2 : 1);
#pragma unroll 1
            for (int x = 0; x < ntile; ++x) { const int rtx = x ? 0 : rt, ctx = x ? wave - 2 : ct; SCAN_UPPROJ_T(rtx, ctx); }
        }
        lds_barrier();
        if (wave >= 4) {
            const int cq = wave - 4; const int fo = (r16 * CS + g4 * 8) * 2, so = ((cq * 16 + r16) * CS + g4 * 8) * 2, uo = ((cq * 16 + r16) * CS2 + g4 * 8) * 2;
#pragma unroll 1
            for (int sub = 0; sub < 2; ++sub) {
                LAS unsigned char* img = ldsb + LB_OPS + sub * IMG_SIZE;
                f32x4 acc_y = (f32x4){0.f, 0.f, 0.f, 0.f}, acc_rhs = (f32x4){0.f, 0.f, 0.f, 0.f};
#pragma unroll
                for (int ks = 0; ks < 2; ++ks) { const bf16x8 sbf = *(const LAS bf16x8*)(ldsb + LB_S0B + so + ks * 64);
                    acc_rhs = __builtin_amdgcn_mfma_f32_16x16x32_bf16(*(const LAS bf16x8*)(img + IMG_AT + fo + ks * 64), sbf, acc_rhs, 0, 0, 0);
                    acc_y = __builtin_amdgcn_mfma_f32_16x16x32_bf16(*(const LAS bf16x8*)(img + IMG_RT + fo + ks * 64), sbf, acc_y, 0, 0, 0); }
                acc_rhs = __builtin_amdgcn_mfma_f32_16x16x32_bf16(*(const LAS bf16x8*)(img + IMG_A3 + (r16 * CS2 + g4 * 8) * 2), *(const LAS bf16x8*)(img + IMG_UVT + uo), acc_rhs, 0, 0, 0);
                const f32x4 tf = *(const LAS f32x4*)(img + IMG_LF + (r16 * 16 + g4 * 4) * 4);
                f32x4 uacc = (f32x4){0.f, 0.f, 0.f, 0.f};
#pragma unroll
                for (int ks = 0; ks < 4; ++ks) uacc = __builtin_amdgcn_mfma_f32_16x16x4f32(tf[ks], acc_rhs[ks], uacc, 0, 0, 0);
                u32x2 uw; uw.x = cvt_pk_bf16(uacc[0], uacc[1]); uw.y = cvt_pk_bf16(uacc[2], uacc[3]);
                *(LAS u32x2*)(img + IMG_UVT + ((cq * 16 + r16) * CS2 + g4 * 4) * 2) = uw;
                asm volatile("s_waitcnt lgkmcnt(0)" ::: "memory");
                const bf16x8 ua = *(const LAS bf16x8*)(img + IMG_UVT + uo);
                acc_y = __builtin_amdgcn_mfma_f32_16x16x32_bf16(*(const LAS bf16x8*)(img + IMG_A2 + (r16 * CS2 + g4 * 8) * 2), ua, acc_y, 0, 0, 0);
#pragma unroll
                for (int e = 0; e < 4; ++e) Yb[(sub * 16 + g4 * 4 + e) * 64 + cq * 16 + r16] = acc_y[e];
#pragma unroll
                for (int jt = 0; jt < 4; ++jt) {
                    accS[jt] = __builtin_amdgcn_mfma_f32_16x16x32_bf16(ua, *(const LAS bf16x8*)(img + IMG_BKT + ((jt * 16 + r16) * CS2 + g4 * 8) * 2), accS[jt], 0, 0, 0);
                    const float pj = *(const LAS float*)(img + IMG_PV + (jt * 16 + r16) * 4);
                    accS[jt] = accS[jt] * pj;
#pragma unroll
                    for (int e = 0; e < 4; ++e) { const unsigned wv = cvt_pk_bf16(accS[jt][e], accS[jt][e]);
                        *(LAS bf16_t*)(ldsb + LB_S0B + ((cq * 16 + g4 * 4 + e) * CS + jt * 16 + r16) * 2) = (bf16_t)(wv & 0xffffu); } }
                asm volatile("s_waitcnt lgkmcnt(0)" ::: "memory");
            }
        } else if (chn + 1 < T / TC) {
#pragma unroll
            for (int x = 0; x < 2; ++x) { const int tl = wave * 2 + x, sbn = tl >> 2, ctn = tl & 3;
                SCAN_LW_ROW(sbn * 16 + (lane >> 2), ctn * 16 + (lane & 3) * 4);
                asm volatile("s_waitcnt lgkmcnt(0)" ::: "memory");
                SCAN_CUMSUM(sbn, ctn); }
        }
        lds_barrier();
    }
    SCAN_POST(T - TC, gg, bonv);
#undef SCAN_PF_LO
#undef SCAN_PF_RKV
#undef SCAN_LO_COPY
#undef SCAN_UPPROJ_T
#undef SCAN_POST
#undef SCAN_LW_ROW
#undef SCAN_CUMSUM
    lds_barrier();
}

__device__ void conv_item(KParamsPtr p, int l, int tile, LAS unsigned char* ldsb) {
    const int tid = otid(), wave = tid >> 6, lane = tid & 63;
    const bf16_t* proj = (const bf16_t*)(p->ws + WS_PROJ);
    bf16_t* merged = (bf16_t*)(g_buf + G_MERGED);
    const int b = tile >> 6, t0 = (tile & 63) * 32;
    LAS unsigned* G = (LAS unsigned*)ldsb;
    LAS float* part = (LAS float*)(ldsb + 63 * 2048);
    for (int i = tid; i < 63 * 128; i += 512) { const int r = i >> 7, c16 = i & 127; const int t = t0 - 30 + r;
        u32x4 v = (u32x4){0u, 0u, 0u, 0u};
        if (t >= 0 && r < 62) v = *(const u32x4*)(proj + ((size_t)b * T + t) * LDP + OFF_GLU + c16 * 8);
        *(LAS u32x4*)(ldsb + r * 2048 + c16 * 16) = v; }
    const int c0 = tid * 2;
    unsigned gbw[32];
#pragma unroll
    for (int t = 0; t < 32; ++t) gbw[t] = *(const unsigned*)(proj + ((size_t)b * T + t0 + t) * LDP + OFF_GB + c0);
    lds_barrier();
    float z0[32], z1[32];
    { const f32x2 cb = *(const f32x2*)(p->conv_b + l * 1024 + c0);
#pragma unroll
      for (int t = 0; t < 32; ++t) { z0[t] = cb.x; z1[t] = cb.y; } }
    const float* cw = p->conv_w + (size_t)l * 31 * 1024 + c0;
    f32x2 wc[4], wn[4];
#pragma unroll
    for (int q = 0; q < 4; ++q) wc[q] = *(const f32x2*)(cw + q * 1024);
#pragma unroll 1
    for (int jb = 0; jb < 32; jb += 4) {
#pragma unroll
        for (int q = 0; q < 4; ++q) { const int jn = jb + 4 + q; wn[q] = (f32x2){0.f, 0.f}; if (jn < 31) wn[q] = *(const f32x2*)(cw + jn * 1024); }
        float g0[35], g1[35];
#pragma unroll
        for (int r = 0; r < 35; ++r) { const unsigned gw = G[(jb + r) * 512 + tid]; g0[r] = bflo(gw); g1[r] = bfhi(gw); }
#pragma unroll
        for (int q = 0; q < 4; ++q) {
#pragma unroll
            for (int t = 0; t < 32; ++t) { z0[t] += g0[t + q] * wc[q].x; z1[t] += g1[t + q] * wc[q].y; } }
#pragma unroll
        for (int q = 0; q < 4; ++q) wc[q] = wn[q];
    }
#pragma unroll
    for (int t = 0; t < 32; ++t) { float s1 = z0[t] + z1[t], s2 = z0[t] * z0[t] + z1[t] * z1[t]; s1 = red64(s1); s2 = red64(s2);
        if (lane == 0) { part[(t * 8 + wave) * 2] = s1; part[(t * 8 + wave) * 2 + 1] = s2; } }
    lds_barrier();
    const f32x2 lg = *(const f32x2*)(p->conv_ln_gain + l * 1024 + c0), lb = *(const f32x2*)(p->conv_ln_bias + l * 1024 + c0);
#pragma unroll
    for (int t = 0; t < 32; ++t) { float s1 = 0.f, s2 = 0.f;
#pragma unroll
        for (int w = 0; w < 8; ++w) { s1 += part[(t * 8 + w) * 2]; s2 += part[(t * 8 + w) * 2 + 1]; }
        const float mean = s1 * (1.0f / 1024.0f); const float var = fmaxf(s2 * (1.0f / 1024.0f) - mean * mean, 0.f); const float rstd = rsqrtf(var + 1e-5f);
        const size_t row = (size_t)b * T + t0 + t;
        const unsigned gw = gbw[t];
        float y0 = (z0[t] - mean) * rstd * lg.x + lb.x, y1 = (z1[t] - mean) * rstd * lg.y + lb.y;
        y0 = y0 * sigm(y0) * bflo(gw); y1 = y1 * sigm(y1) * bfhi(gw);
        *(unsigned*)(merged + row * 2048 + 1024 + c0) = cvt_pk_bf16(y0, y1); }
    lds_barrier();
}

__device__ void mixer_phase(KParamsPtr p, int l, LAS unsigned char* ldsb, const bool grp2) {
    const int G = gridDim.x; const int NS = G >= 256 ? 128 : (G / 2 > 0 ? G / 2 : 1);
    int* done = (int*)(p->ws + WS_CTR) + 4 + l;
    if (grp2) {
        asm volatile("s_waitcnt vmcnt(0)" ::: "memory");
        __syncthreads();
        if (otid() == 0) { __builtin_amdgcn_fence(__ATOMIC_RELEASE, "agent"); asm volatile("s_waitcnt vmcnt(0)" ::: "memory"); __hip_atomic_fetch_add(done, 1, __ATOMIC_RELAXED, __HIP_MEMORY_SCOPE_AGENT); }
    }
    if ((int)blockIdx.x < NS) { for (int it = blockIdx.x; it < 128; it += NS) scan_item(p, l, it >> 4, it & 15, ldsb); }
    if (G == 256) {
        if (otid() == 0) { unsigned sp = 0u; while (__hip_atomic_load(done, __ATOMIC_RELAXED, __HIP_MEMORY_SCOPE_AGENT) < 128) { __builtin_amdgcn_s_sleep(4); if (++sp > (1u << 20)) break; }
            __builtin_amdgcn_fence(__ATOMIC_ACQUIRE, "agent"); asm volatile("s_waitcnt vmcnt(0)" ::: "memory"); }
        __syncthreads();
    }
    int* ctr = (int*)(p->ws + WS_CTR) + l; LAS int* slot = (LAS int*)(ldsb + 63 * 2048 + 2048);
    const int tid = otid();
    for (;;) {
        if (tid == 0) *slot = atomicAdd(ctr, 1);
        __syncthreads();
        const int tile = *slot;
        __syncthreads();
        if (tile >= 512) break;
        conv_item(p, l, tile, ldsb);
    }
    {
        int* ctr2 = (int*)(p->ws + WS_CTR) + 2 + l; const int nq = l == 0 ? PREP_B0 : PREP_B1;
        for (;;) {
            if (tid == 0) *slot = atomicAdd(ctr2, 1);
            __syncthreads();
            const int q = *slot;
            __syncthreads();
            if (q >= nq) break;
            prep_job(p, prep_b_job(l, q), (LAS float*)ldsb);
        }
    }
}

#define XB_TMO      128
#define XB_XCNT(j)  (256  + 64 * (j))
#define XB_XSUB(j)  (1280 + 64 * (j))
#define XB_XGEN(j)  (2304 + 64 * (j))
#define XB_TOP      3328
#define XB_TOPGEN   3392
#define XCD_BAR_WORDS 3456
#define XB_SPIN_CAP (1u << 18)

__device__ __forceinline__ unsigned xb_ld(unsigned* p)              { return __hip_atomic_load(p, __ATOMIC_RELAXED, __HIP_MEMORY_SCOPE_AGENT); }
__device__ __forceinline__ unsigned xb_add(unsigned* p, unsigned v) { return __hip_atomic_fetch_add(p, v, __ATOMIC_RELAXED, __HIP_MEMORY_SCOPE_AGENT); }
__device__ __forceinline__ unsigned xb_xcc_id() { return (unsigned)__builtin_amdgcn_s_getreg((3 << 11) | 20) & 0xFu; }
#define XB_SPIN(cond, bar) do { unsigned _sp = 0; while (cond) { __builtin_amdgcn_s_sleep(1); \
    if ((++_sp & 255u) == 0u) { if (xb_ld(&(bar)[XB_TMO])) break; if (_sp > XB_SPIN_CAP) { atomicAdd(&(bar)[XB_TMO], 1u); break; } } } } while (0)

struct XcdBarrier {
    unsigned* bar; unsigned x;
    volatile LAS unsigned* st;
};

__device__ __forceinline__ XcdBarrier xcd_barrier_post(unsigned* bar, volatile LAS unsigned* st) {
    XcdBarrier b; b.bar = bar; b.x = xb_xcc_id(); b.st = st;
    if (threadIdx.x == 0) (void)xb_add(&bar[XB_XCNT(b.x)], 1u);
    return b;
}
__device__ __forceinline__ void xcd_barrier_complete(unsigned* bar, unsigned x, unsigned& nloc, unsigned& nx) {
    const unsigned G = gridDim.x * gridDim.y * gridDim.z;
    unsigned sum, cnt, mine, sp = 0u;
    for (;;) {
        sum = 0u; cnt = 0u; mine = 0u;
#pragma unroll
        for (unsigned j = 0; j < 16; ++j) { const unsigned c = xb_ld(&bar[XB_XCNT(j)]); sum += c; cnt += (c > 0u) ? 1u : 0u; mine = (j == x) ? c : mine; }
        if (sum == G) break;
        __builtin_amdgcn_s_sleep(1);
        if ((++sp & 255u) == 0u) { if (xb_ld(&bar[XB_TMO])) break; if (sp > XB_SPIN_CAP) { atomicAdd(&bar[XB_TMO], 1u); break; } }
    }
    nloc = mine > 0u ? mine : 1u; nx = cnt > 0u ? cnt : 1u;
}

__device__ __forceinline__ void xcd_barrier(const XcdBarrier& b) {
    asm volatile("s_waitcnt vmcnt(0)" ::: "memory");
    __syncthreads();
    if (threadIdx.x == 0) {
        unsigned* bar = b.bar;
        __builtin_amdgcn_s_waitcnt(0);
        unsigned nloc = b.st[0], nx = b.st[1];
        if (nloc == 0u) { xcd_barrier_complete(bar, b.x, nloc, nx); b.st[0] = nloc; b.st[1] = nx; }
        const unsigned old = xb_add(&bar[XB_XSUB(b.x)], 1u);
        const unsigned gen = old / nloc;
        if (old + 1u == (gen + 1u) * nloc) {
            __builtin_amdgcn_fence(__ATOMIC_RELEASE, "agent");
            asm volatile("s_waitcnt vmcnt(0)" ::: "memory");
            const unsigned og = xb_add(&bar[XB_TOP], 1u);
            const unsigned tg = og / nx;
            if (og + 1u == (tg + 1u) * nx) xb_add(&bar[XB_TOPGEN], 1u);
            else XB_SPIN(xb_ld(&bar[XB_TOPGEN]) == tg, bar);
            __builtin_amdgcn_fence(__ATOMIC_ACQUIRE, "agent");
            xb_add(&bar[XB_XGEN(b.x)], 1u);
            asm volatile("s_waitcnt vmcnt(0)" ::: "memory");
        } else {
            XB_SPIN(xb_ld(&bar[XB_XGEN(b.x)]) == gen, bar);
            __builtin_amdgcn_fence(__ATOMIC_ACQUIRE, "agent");
            asm volatile("s_waitcnt vmcnt(0)" ::: "memory");
        }
    }
    __syncthreads();
}

static_assert(XCD_BAR_WORDS * 4 <= 16384, "barrier words");

constexpr int NPHASE = 20;
__global__ void __launch_bounds__(512, 2) mega(Params p_unused, int ph_lo, int ph_hi) {
    extern __shared__ __attribute__((aligned(16))) unsigned char shm[];
    LAS unsigned char* lds = (LAS unsigned char*)shm;
    cg::grid_group grid = cg::this_grid();
    volatile LAS unsigned* bst = (volatile LAS unsigned*)(lds + LDS_BYTES - 16);
    if (threadIdx.x == 0) { bst[0] = 0u; bst[1] = 0u; }
    __syncthreads();
    XcdBarrier gbar;
    { KParamsPtr p0 = (KParamsPtr)__builtin_amdgcn_kernarg_segment_ptr(); gbar = xcd_barrier_post((unsigned*)(p0->ws + WS_BAR), bst); }
    for (int ph = ph_lo; ph < ph_hi; ++ph) {
        KParamsPtr p = (KParamsPtr)__builtin_amdgcn_kernarg_segment_ptr();
        asm volatile("" : "+s"(p));
        bf16_t* proj = (bf16_t*)(p->ws + WS_PROJ); bf16_t* hbuf = (bf16_t*)(p->ws + WS_H); float* mod = (float*)(p->ws + WS_MOD);
        bf16_t* merged = (bf16_t*)(g_buf + G_MERGED);
        if (ph == 0) prep_phase(p, (LAS float*)lds);
        else if (ph == NPHASE - 1) final_norm_phase(p->out, p->final_gain);
        else {
            const int l = (ph - 1) / 9, s = (ph - 1) % 9;
            const float* modl = mod + (size_t)l * 8 * 6144;
            const float* xcur = (l == 0) ? p->x : p->out;
            if (s == 0) norm_phase(xcur, hbuf, p->norm_mix_gain + l * 1024, modl, 0, 1024);
            else if (s == 2) lo_prep_phase(p, l);
            else if (s == 4) mixer_phase(p, l, lds, gridDim.x == 256 && blockIdx.x >= 128);
            else if (s == 6) norm_phase(p->out, hbuf, p->norm_ffn_gain + l * 1024, modl, 3072, 4096);
            else {
                pg8::Gemm g; pg8::Epi E; g.M = M; E.pn0 = 0; E.lv = l; int Gq = gridDim.x, cq = blockIdx.x; const bool split = gridDim.x == 256;
                if (s == 1) { g.A = hbuf; g.Bt = (const bf16_t*)(g_buf + G_WIN) + (size_t)l * 7680 * 1024; g.N = (split ? 17 + l : 29 + l) * 256; g.K = 1024; E.kind = 0; E.O = proj; E.xin = nullptr; E.xout = nullptr; E.gate = nullptr; }
                else if (s == 3) { g.A = hbuf; g.Bt = (const bf16_t*)(g_buf + G_WIN) + (size_t)l * 7680 * 1024 + (size_t)(17 + l) * 256 * 1024; g.N = 12 * 256; g.K = 1024; E.kind = 0; E.O = proj; E.xin = nullptr; E.xout = nullptr; E.gate = nullptr; E.pn0 = 17 + l;
                    Gq = 128; cq = (split && blockIdx.x >= 128) ? (int)blockIdx.x - 128 : (1 << 20); }
                else if (s == 5) { g.A = merged; g.Bt = (const bf16_t*)(g_buf + G_WOUT) + (size_t)l * 1024 * 2048; g.N = 1024; g.K = 2048; E.kind = 2; E.O = nullptr; E.xin = xcur; E.xout = p->out; E.gate = modl + 2048; }
                else if (s == 7) { g.A = hbuf; g.Bt = (const bf16_t*)(g_buf + G_WF1) + (size_t)l * 4096 * 1024; g.N = 4096; g.K = 1024; E.kind = 1; E.O = proj; E.xin = nullptr; E.xout = nullptr; E.gate = nullptr; }
                else { g.A = proj; g.Bt = (const bf16_t*)(g_buf + G_WF2) + (size_t)l * 1024 * 4096; g.N = 1024; g.K = 4096; E.kind = 2; E.O = nullptr; E.xin = p->out; E.xout = p->out; E.gate = modl + 5120; }
                pg8::StaticOrder S; S.init(M, g.N, Gq, cq);
                pg8::gemm_phase(lds, g, S, E);
            }
        }
        if (ph + 1 < ph_hi && !(ph > 0 && ph < NPHASE - 1 && (ph - 1) % 9 == 3)) { if (ph_hi > NPHASE) grid.sync(); else xcd_barrier(gbar); }
    }
}

extern "C" void kernel_launch(void* const* d_in, const int* in_sizes, int n_in, void* d_out, int out_size, void* d_ws, size_t ws_size, hipStream_t stream) {
    static int grid = 0;
    if (grid == 0) {
        if (n_in != 30 || out_size != M * D || ws_size < WS_END) { fprintf(stderr, "kernel_launch: unexpected shapes (n_in %d out %d ws %zu need %zu)\n", n_in, out_size, ws_size, (size_t)WS_END); grid = -1; return; }
        int dev = 0, cus = 0, per_cu = 0;
        hipGetDevice(&dev); hipDeviceGetAttribute(&cus, hipDeviceAttributeMultiprocessorCount, dev);
        if (hipFuncSetAttribute((const void*)mega, hipFuncAttributeMaxDynamicSharedMemorySize, LDS_BYTES) != hipSuccess) { fprintf(stderr, "kernel_launch: hipFuncSetAttribute failed\n"); grid = -1; return; }
        if (hipOccupancyMaxActiveBlocksPerMultiprocessor(&per_cu, (const void*)mega, 512, LDS_BYTES) != hipSuccess || per_cu < 1) { fprintf(stderr, "kernel_launch: occupancy query gave %d\n", per_cu); per_cu = 1; }
        (void)hipGetLastError();
        grid = cus * per_cu;
        if (grid > 256) grid = 256;
    }
    if (grid < 0) return;
    Params p{};
    const float** pp = (const float**)&p;
    for (int i = 0; i < 30; ++i) pp[i] = (const float*)d_in[i];
    p.out = (float*)d_out; p.ws = (unsigned char*)d_ws;
#if MULTI_LAUNCH
    for (int ph = 0; ph < NPHASE; ++ph) hipLaunchKernelGGL(mega, dim3(grid), dim3(512), LDS_BYTES, stream, p, ph, ph + 1);
#else
    if (hipMemsetAsync((char*)d_ws + WS_BAR, 0, 16384, stream) != hipSuccess) { fprintf(stderr, "kernel_launch: memset of the barrier words failed\n"); return; }
    int lo = 0, hi = NPHASE;
    void* args[] = {&p, &lo, &hi};
    hipError_t e = hipLaunchCooperativeKernel((const void*)mega, dim3(grid), dim3(512), args, LDS_BYTES, stream);
    if (e != hipSuccess) fprintf(stderr, "cooperative launch failed: %s (grid %d)\n", hipGetErrorString(e), grid);
#endif
}
```
